# Optimizing an MI355X kernel written in HIP

```python
import math
import jax, jax.numpy as jnp
from jax import lax
import numpy as np

D_MODEL = 1024
BATCH = 32
SEQ = 2048
DEPTH = 4
DEC_BATCH = 8
DEC_SEQ = 4096
PAST_LEN = 128

HEAD_DIM = 64
CHUNK = 128
A_GROUPS = 8
W_A = A_GROUPS * HEAD_DIM
DILATED_GROUPS = ((128, 1), (512, 4), (2048, 16))
HEADS_PER_GROUP = 2
H_B = HEADS_PER_GROUP * len(DILATED_GROUPS)
W_B = H_B * HEAD_DIM
H_C = 4
W_C_QK = 2 * H_C * HEAD_DIM
W_C = H_C * 2 * HEAD_DIM
N_ATTN_HEADS = H_B + H_C
NUM_BUCKETS = 32
REL_MAX_DIST = 1024
QBLK = 128
D_FF = ((8 * D_MODEL + 3 * 256 - 1) // (3 * 256)) * 256
N_BRANCH = 3
SPLIT_SIZES = (2 * W_A, 3 * W_B, 2 * W_C_QK + W_C, N_BRANCH * D_MODEL)
IN_COLS = sum(SPLIT_SIZES)
SPLIT_POINTS = tuple(int(c) for c in np.cumsum(SPLIT_SIZES)[:-1])
RMS_EPS = 1e-6
LN_EPS = 1e-5
NEG_INF = -1e30

kernel_name = 'hybrid_gated_gmlp_dilated_diff_encoder'


def rms_norm(x, g):
    xf = x.astype(jnp.float32)
    y = xf * lax.rsqrt(jnp.mean(xf * xf, axis=-1, keepdims=True) + RMS_EPS)
    return (y * g.astype(jnp.float32)).astype(x.dtype)


def layer_norm(x, g, b):
    xf = x.astype(jnp.float32)
    xc = xf - jnp.mean(xf, axis=-1, keepdims=True)
    var = jnp.mean(xc * xc, axis=-1, keepdims=True)
    return (xc * lax.rsqrt(var + LN_EPS) * g.astype(jnp.float32) + b.astype(jnp.float32)).astype(x.dtype)


def rel_bucket(rel):
    nb = NUM_BUCKETS // 2
    max_exact = nb // 2
    n = jnp.abs(rel)
    sign_off = jnp.where(rel > 0, nb, 0)
    nf = jnp.maximum(n, 1).astype(jnp.float32)
    large = max_exact + (jnp.log(nf / max_exact) / math.log(REL_MAX_DIST / max_exact)
                         * (nb - max_exact)).astype(jnp.int32)
    large = jnp.minimum(large, nb - 1)
    return sign_off + jnp.where(n < max_exact, n, large)


def banded_attention(q, k, v, bias, half):
    n, L, h, hd = q.shape
    nb = -(-L // half)
    lp = nb * half
    pad = lp - L
    qp = jnp.pad(q, ((0, 0), (0, pad), (0, 0), (0, 0))).reshape(n, nb, half, h, hd)

    def windows(t):
        tp = jnp.pad(t, ((0, 0), (half, pad + half), (0, 0), (0, 0))).reshape(n, nb + 2, half, h, t.shape[-1])
        return jnp.concatenate([tp[:, :-2], tp[:, 1:-1], tp[:, 2:]], axis=2)

    kw = windows(k)
    vw = windows(v)
    s = jnp.einsum('nbqhd,nbkhd->nbhqk', qp, kw).astype(jnp.float32) + bias.astype(jnp.float32)[None, None]
    qpos = jnp.arange(nb)[:, None] * half + jnp.arange(half)[None, :]
    kpos = (jnp.arange(nb)[:, None] - 1) * half + jnp.arange(3 * half)[None, :]
    kp3 = kpos[:, None, :]
    valid = (kp3 >= 0) & (kp3 < L) & (jnp.abs(kp3 - qpos[:, :, None]) <= half)
    s = jnp.where(valid[None, :, None], s, NEG_INF)
    lse = jax.nn.logsumexp(s, axis=-1)
    p = jnp.exp(s - lse[..., None])
    o = jnp.einsum('nbhqk,nbkhd->nbqhd', p.astype(v.dtype), vw).reshape(n, lp, h, v.shape[-1])[:, :L]
    lse = jnp.swapaxes(lse, 2, 3).reshape(n, lp, h)[:, :L]
    return o, lse


def dilated_attention(q, k, v, table, window, dil):
    b, s, h, hd = q.shape
    half = window // (2 * dil)
    sub = s // dil

    def to_sub(t):
        return jnp.swapaxes(t.reshape(b, sub, dil, h, t.shape[-1]), 1, 2).reshape(b * dil, sub, h, t.shape[-1])

    rel = (jnp.arange(3 * half)[None, :] - half - jnp.arange(half)[:, None]) * dil
    bias = jnp.transpose(table[rel_bucket(rel)], (2, 0, 1))
    o, lse = banded_attention(to_sub(q), to_sub(k), to_sub(v), bias, half)
    o = jnp.swapaxes(o.reshape(b, dil, sub, h, hd), 1, 2).reshape(b, s, h, hd)
    lse = jnp.swapaxes(lse.reshape(b, dil, sub, h), 1, 2).reshape(b, s, h)
    return o, lse


def diff_attention(q, k, v, table, lam):
    b, s, _, h, hd = q.shape
    nq = s // QBLK
    q_blocks = jnp.moveaxis(q.reshape(b, nq, QBLK, 2, h, hd), 1, 0)
    starts = jnp.arange(nq, dtype=jnp.int32) * QBLK
    kpos = jnp.arange(s, dtype=jnp.int32)

    def one_block(args):
        qi, q0 = args
        logits = jnp.einsum('bqchd,bkchd->bchqk', qi, k).astype(jnp.float32)
        rel = kpos[None, :] - (q0 + jnp.arange(QBLK, dtype=jnp.int32))[:, None]
        bias = jnp.transpose(table[rel_bucket(rel)], (2, 0, 1)).astype(jnp.float32)
        probs = jax.nn.softmax(logits + bias[None, None], axis=-1)
        attn = probs[:, 0] - lam * probs[:, 1]
        return jnp.einsum('bhqk,bkhe->bqhe', attn.astype(v.dtype), v)

    o = lax.map(one_block, (q_blocks, starts))
    return jnp.moveaxis(o, 0, 1).reshape(b, s, h, v.shape[-1])


def encoder_layer(x, p, l):
    b, s, _ = x.shape
    lam_init = 0.8 - 0.6 * math.exp(-0.3 * l)
    h = rms_norm(x, p['norm1_g'][l])
    z = h @ p['w_in'][l]
    za, zb, zc, zg = jnp.split(z, SPLIT_POINTS, axis=-1)

    u, v = jnp.split(jax.nn.gelu(za), 2, axis=-1)
    vn = layer_norm(v, p['sgu_ln_g'][l], p['sgu_ln_b'][l]).reshape(b, s // CHUNK, CHUNK, A_GROUPS, HEAD_DIM)
    sv = jnp.einsum('gpq,bcqgd->bcpgd', p['sgu_w'][l], vn) + p['sgu_b'][l].T[None, None, :, :, None]
    a_out = u * sv.reshape(b, s, W_A)

    qb, kb, vb = (t.reshape(b, s, H_B, HEAD_DIM) for t in jnp.split(zb, 3, axis=-1))
    qb = rms_norm(qb, p['qn_b'][l]) * HEAD_DIM ** -0.5
    kb = rms_norm(kb, p['kn_b'][l])
    outs, lses = [], []
    for gi, (window, dil) in enumerate(DILATED_GROUPS):
        hs = slice(gi * HEADS_PER_GROUP, (gi + 1) * HEADS_PER_GROUP)
        o_g, lse_g = dilated_attention(qb[:, :, hs], kb[:, :, hs], vb[:, :, hs], p['rel_bias'][:, hs], window, dil)
        outs.append(o_g)
        lses.append(lse_g)
    o_b = jnp.stack(outs, axis=2)
    alpha = jax.nn.softmax(jnp.stack(lses, axis=2), axis=2)
    b_out = (o_b * alpha[..., None].astype(o_b.dtype)).reshape(b, s, W_B)

    qc, kc, vc = jnp.split(zc, (W_C_QK, 2 * W_C_QK), axis=-1)
    qc = rms_norm(qc.reshape(b, s, 2, H_C, HEAD_DIM), p['qn_c'][l]) * HEAD_DIM ** -0.5
    kc = rms_norm(kc.reshape(b, s, 2, H_C, HEAD_DIM), p['kn_c'][l])
    vc = vc.reshape(b, s, H_C, 2 * HEAD_DIM)
    lq1 = p['lam_q1'][l].astype(jnp.float32)
    lk1 = p['lam_k1'][l].astype(jnp.float32)
    lq2 = p['lam_q2'][l].astype(jnp.float32)
    lk2 = p['lam_k2'][l].astype(jnp.float32)
    lam = jnp.exp(jnp.sum(lq1 * lk1)) - jnp.exp(jnp.sum(lq2 * lk2)) + lam_init
    o_c = diff_attention(qc, kc, vc, p['rel_bias'][:, H_B:], lam)
    c_out = (rms_norm(o_c, p['subln_g'][l]) * (1.0 - lam_init)).reshape(b, s, W_C)

    gates = jax.nn.sigmoid(zg.astype(jnp.float32)).astype(x.dtype).reshape(b, s, N_BRANCH, D_MODEL)
    merged = (gates[:, :, 0] * (a_out @ p['w_pa'][l])
              + gates[:, :, 1] * (b_out @ p['w_pb'][l])
              + gates[:, :, 2] * (c_out @ p['w_pc'][l]))
    x = x + merged @ p['w_o'][l]

    h2 = rms_norm(x, p['norm2_g'][l])
    g_ff, u_ff = jnp.split(h2 @ p['w_gu'][l], 2, axis=-1)
    return x + (jax.nn.silu(g_ff) * u_ff) @ p['w_down'][l]


def encoder_trunk(x, p):
    for l in range(DEPTH):
        x = encoder_layer(x, p, l)
    return x


def setup_inputs(seed: int = 0) -> dict:
    key = jax.random.key(seed)
    ks = jax.random.split(key, 32)

    def nrm(k, shape, scale):
        return jax.random.normal(k, shape, jnp.float32) * scale

    def gain(k, shape):
        return 1.0 + 0.05 * jax.random.normal(k, shape, jnp.float32)

    return {
        'x_prompt': nrm(ks[0], (BATCH, SEQ, D_MODEL), 1.0),
        'x_sample': nrm(ks[1], (DEC_BATCH, DEC_SEQ, D_MODEL), 1.0),
        'rel_bias': nrm(ks[2], (NUM_BUCKETS, N_ATTN_HEADS), 0.5),
        'norm1_g': gain(ks[3], (DEPTH, D_MODEL)),
        'w_in': nrm(ks[4], (DEPTH, D_MODEL, IN_COLS), D_MODEL ** -0.5),
        'sgu_ln_g': gain(ks[5], (DEPTH, W_A)),
        'sgu_ln_b': nrm(ks[6], (DEPTH, W_A), 0.02),
        'sgu_w': nrm(ks[7], (DEPTH, A_GROUPS, CHUNK, CHUNK), CHUNK ** -0.5),
        'sgu_b': 1.0 + nrm(ks[8], (DEPTH, A_GROUPS, CHUNK), 0.1),
        'qn_b': gain(ks[9], (DEPTH, HEAD_DIM)),
        'kn_b': gain(ks[10], (DEPTH, HEAD_DIM)),
        'qn_c': gain(ks[11], (DEPTH, HEAD_DIM)),
        'kn_c': gain(ks[12], (DEPTH, HEAD_DIM)),
        'lam_q1': nrm(ks[13], (DEPTH, HEAD_DIM), 0.1),
        'lam_k1': nrm(ks[14], (DEPTH, HEAD_DIM), 0.1),
        'lam_q2': nrm(ks[15], (DEPTH, HEAD_DIM), 0.1),
        'lam_k2': nrm(ks[16], (DEPTH, HEAD_DIM), 0.1),
        'subln_g': gain(ks[17], (DEPTH, 2 * HEAD_DIM)),
        'w_pa': nrm(ks[18], (DEPTH, W_A, D_MODEL), W_A ** -0.5),
        'w_pb': nrm(ks[19], (DEPTH, W_B, D_MODEL), W_B ** -0.5),
        'w_pc': nrm(ks[20], (DEPTH, W_C, D_MODEL), W_C ** -0.5),
        'w_o': nrm(ks[21], (DEPTH, D_MODEL, D_MODEL), D_MODEL ** -0.5),
        'norm2_g': gain(ks[22], (DEPTH, D_MODEL)),
        'w_gu': nrm(ks[23], (DEPTH, D_MODEL, 2 * D_FF), D_MODEL ** -0.5),
        'w_down': nrm(ks[24], (DEPTH, D_FF, D_MODEL), D_FF ** -0.5),
    }


def reference(x_prompt, x_sample, rel_bias, norm1_g, w_in, sgu_ln_g, sgu_ln_b, sgu_w, sgu_b,
              qn_b, kn_b, qn_c, kn_c, lam_q1, lam_k1, lam_q2, lam_k2, subln_g,
              w_pa, w_pb, w_pc, w_o, norm2_g, w_gu, w_down):
    params = dict(rel_bias=rel_bias, norm1_g=norm1_g, w_in=w_in, sgu_ln_g=sgu_ln_g, sgu_ln_b=sgu_ln_b,
                  sgu_w=sgu_w, sgu_b=sgu_b, qn_b=qn_b, kn_b=kn_b, qn_c=qn_c, kn_c=kn_c,
                  lam_q1=lam_q1, lam_k1=lam_k1, lam_q2=lam_q2, lam_k2=lam_k2, subln_g=subln_g,
                  w_pa=w_pa, w_pb=w_pb, w_pc=w_pc, w_o=w_o, norm2_g=norm2_g, w_gu=w_gu, w_down=w_down)
    y_prompt = encoder_trunk(x_prompt, params)
    y_sample = encoder_trunk(x_sample, params)
    return (y_prompt, y_sample)
```

```cpp
#include <hip/hip_runtime.h>
#include <hip/hip_cooperative_groups.h>
#include <cstdio>
#include <cstdint>
namespace cg = cooperative_groups;
namespace pg8 {
#define PG8_LAS __attribute__((address_space(3)))
typedef unsigned short bf16_t;
typedef short bf16x8 __attribute__((ext_vector_type(8)));
typedef float f32x4 __attribute__((ext_vector_type(4)));
typedef unsigned u32x4 __attribute__((ext_vector_type(4)));
constexpr int BM = 256, BK = 64, HALF = 128, HTB = HALF * BK * 2  , STAGE_BYTES = 8 * HTB, NXCD = 8, WGM = 8;

__host__ __device__ __forceinline__ int lds_byte(int r, int c) { const int st = (r >> 4) * 2 + (c >> 5), rr = r & 15, cc = c & 31, ob = rr * 64 + cc * 2; return st * 1024 + (ob ^ (((ob >> 9) & 1) << 5)); }
__host__ __device__ __forceinline__ void stage_rc(int b, int& R, int& C) { const int st = b / 1024, sb = b % 1024, swz = sb ^ (((sb >> 9) & 1) << 5); R = (st >> 1) * 16 + swz / 64; C = (st & 1) * 32 + (swz % 64) / 2; }
__host__ __device__ __forceinline__ int perm32(int rho) { const int n = rho >> 4, i = rho & 15; return 8 * (i >> 2) + 4 * n + (i & 3); }

struct Unit { int pm, pn; };
struct Gemm { const bf16_t* A; const bf16_t* Bt; int M, N, K; };

struct StaticOrder {
    int nM, nN, nwg, G, c;
    __host__ __device__ void init(int M, int N, int G_, int c_) { nM = M / BM; nN = N / BM; nwg = nM * nN; G = G_; c = c_; }
    __host__ __device__ bool next(int i, Unit& u) const {
        const long L = (long)i * G + c; if (L >= nwg) return false;
        int wgid = (int)L; { const int q = nwg / NXCD, r = nwg % NXCD, xcd = wgid % NXCD, off = wgid / NXCD; wgid = (xcd < r ? xcd * (q + 1) : r * (q + 1) + (xcd - r) * q) + off; }
        const int nig = WGM * nN, gid = wgid / nig, fm = gid * WGM, gsz = (nM - fm) < WGM ? (nM - fm) : WGM;
        u.pm = fm + ((wgid % nig) % gsz); u.pn = (wgid % nig) / gsz; return true;
    }
    __device__ __forceinline__ void a_ready(const Unit&) const {}
    __device__ __forceinline__ void done(const Unit&) const {}
};

__device__ __forceinline__ unsigned cvt_pk_bf16(float lo, float hi) { unsigned r; asm volatile("v_cvt_pk_bf16_f32 %0, %1, %2" : "=v"(r) : "v"(lo), "v"(hi)); return r; }
template <class Epi, class Sched, bool ALIGN_EPI = false, bool SP2 = false>
__device__ __forceinline__ void gemm_phase(PG8_LAS unsigned char* lds, const Gemm g, const Sched& S, const Epi& E) {
    int tid_ = threadIdx.x; asm volatile("" : "+v"(tid_));
    const int tid = tid_, wid = __builtin_amdgcn_readfirstlane(tid >> 6), lane = tid & 63, wr = wid >> 2, wc = wid & 3, fr = lane & 15, fq = lane >> 4;
    const int K = g.K, nt = K / BK;
    unsigned voffA[2], voffB[2];
#pragma unroll
    for (int i = 0; i < 2; ++i) { int R, C; stage_rc(tid * 16 + i * 8192, R, C); const int Rb = Epi::PERM ? ((R & ~31) + perm32(R & 31)) : R;
        voffA[i] = (unsigned)(R * K + C) * 2u; voffB[i] = (unsigned)(Rb * K + C) * 2u; }
    const size_t kstep = (size_t)(BK * 2);
    const size_t hstep = (size_t)HALF * K * 2;
    const size_t tstep = 2 * hstep;
    const unsigned ldsw = (unsigned)wid * 1024u;
    const int aoff = lds_byte(wr * 64 + fr, fq * 8), boff = lds_byte(wc * 32 + fr, fq * 8);
#define PG8_SA(b, h) (((b) * 2 + (h)) * HTB)
#define PG8_SB(b, h) ((4 + (b) * 2 + (h)) * HTB)
#define PG8_STAGE(bufoff, gbase, voff) do { _Pragma("unroll") for (int _i = 0; _i < 2; ++_i) \
        __builtin_amdgcn_global_load_lds((const unsigned*)((const char*)(gbase) + (voff)[_i]), (PG8_LAS unsigned*)(lds + (bufoff) + ldsw + _i * 8192), 16, 0, 0); } while (0)
#define PG8_LDA(dst, b, h) do { _Pragma("unroll") for (int m = 0; m < 4; ++m) _Pragma("unroll") for (int k = 0; k < 2; ++k) dst[m][k] = *(const PG8_LAS bf16x8*)(lds + PG8_SA(b, h) + aoff + m * 2048 + k * 1024); } while (0)
#define PG8_LDB(dst, b, h) do { _Pragma("unroll") for (int n = 0; n < 2; ++n) _Pragma("unroll") for (int k = 0; k < 2; ++k) dst[n][k] = *(const PG8_LAS bf16x8*)(lds + PG8_SB(b, h) + boff + n * 2048 + k * 1024); } while (0)
#define PG8_MMA(ai, bj, At, Bt) do { __builtin_amdgcn_s_setprio(1); _Pragma("unroll") for (int m = 0; m < 4; ++m) _Pragma("unroll") for (int n = 0; n < 2; ++n) _Pragma("unroll") for (int k = 0; k < 2; ++k) \
        acc[ai][bj][m][n] = __builtin_amdgcn_mfma_f32_16x16x32_bf16(Bt[n][k], At[m][k], acc[ai][bj][m][n], 0, 0, 0); __builtin_amdgcn_s_setprio(0); } while (0)
#define PG8_WAIT_V(n) asm volatile("s_waitcnt vmcnt(" #n ")" ::: "memory")
#define PG8_WAIT_L(n) asm volatile("s_waitcnt lgkmcnt(" #n ")" ::: "memory")
#define PG8_BAR __builtin_amdgcn_s_barrier()
#define PG8_SCHED __builtin_amdgcn_sched_barrier(0)
    Unit cur, nxt; int ui = 0;
    if (!S.next(0, cur)) return;
    f32x4 acc[2][2][4][2];
#pragma unroll
    for (int a = 0; a < 2; ++a)
#pragma unroll
        for (int b = 0; b < 2; ++b)
#pragma unroll
            for (int m = 0; m < 4; ++m)
#pragma unroll
                for (int n = 0; n < 2; ++n) acc[a][b][m][n] = (f32x4){0.f, 0.f, 0.f, 0.f};
    bf16x8 At[4][2], B0[2][2], B1[2][2];
    const char* cA = (const char*)g.A + (size_t)cur.pm * tstep; const char* cB = (const char*)g.Bt + (size_t)cur.pn * tstep;
    S.a_ready(cur);
    if constexpr (SP2) {
        PG8_STAGE(PG8_SB(0, 0), cB, voffB); PG8_STAGE(PG8_SB(0, 1), cB + hstep, voffB); PG8_STAGE(PG8_SA(0, 0), cA, voffA); PG8_STAGE(PG8_SA(0, 1), cA + hstep, voffA);
        if (wr == 1) PG8_BAR;
        PG8_WAIT_V(2); PG8_BAR;
        PG8_STAGE(PG8_SB(1, 0), cB + kstep, voffB); PG8_STAGE(PG8_SA(1, 0), cA + kstep, voffA); PG8_STAGE(PG8_SB(1, 1), cB + hstep + kstep, voffB);
        PG8_WAIT_V(6); PG8_BAR;
    } else {
        PG8_STAGE(PG8_SB(0, 0), cB, voffB); PG8_STAGE(PG8_SA(0, 0), cA, voffA); PG8_STAGE(PG8_SB(0, 1), cB + hstep, voffB); PG8_STAGE(PG8_SA(0, 1), cA + hstep, voffA);
        if (wr == 1) PG8_BAR;
        PG8_WAIT_V(4); PG8_BAR;
        PG8_STAGE(PG8_SB(1, 0), cB + kstep, voffB); PG8_STAGE(PG8_SA(1, 0), cA + kstep, voffA); PG8_STAGE(PG8_SB(1, 1), cB + hstep + kstep, voffB);
        PG8_WAIT_V(6); PG8_BAR;
    }
    for (;;) {
        const bool has_next = S.next(ui + 1, nxt);
        const char* nA = has_next ? (const char*)g.A + (size_t)nxt.pm * tstep : cA; const char* nB = has_next ? (const char*)g.Bt + (size_t)nxt.pn * tstep : cB;
        for (int t = 0; t < nt; t += 2) {
            const bool last = (t == nt - 2);
            const char* a1 = cA + (size_t)(t + 1) * kstep;
            const char* a2 = last ? nA : cA + (size_t)(t + 2) * kstep; const char* b2 = last ? nB : cB + (size_t)(t + 2) * kstep;
            const char* a3 = a2 + kstep; const char* b3 = b2 + kstep;
            if (last && has_next) S.a_ready(nxt);
            if constexpr (SP2) {
            PG8_LDB(B0, 0, 0); PG8_LDB(B1, 0, 1); PG8_SCHED; PG8_LDA(At, 0, 0); PG8_STAGE(PG8_SA(1, 1), a1 + hstep, voffA);
            PG8_WAIT_V(8); PG8_WAIT_L(0); PG8_BAR; PG8_MMA(0, 0, At, B0); PG8_MMA(0, 1, At, B1); PG8_BAR; PG8_SCHED;
            PG8_LDA(At, 0, 1); PG8_STAGE(PG8_SB(0, 0), b2, voffB); PG8_STAGE(PG8_SB(0, 1), b2 + hstep, voffB); PG8_STAGE(PG8_SA(0, 0), a2, voffA);
            PG8_WAIT_V(8); PG8_WAIT_L(0); PG8_BAR; PG8_MMA(1, 0, At, B0); PG8_MMA(1, 1, At, B1); PG8_BAR; PG8_SCHED;
            PG8_LDB(B0, 1, 0); PG8_LDB(B1, 1, 1); PG8_SCHED; PG8_LDA(At, 1, 0); PG8_STAGE(PG8_SA(0, 1), a2 + hstep, voffA);
            PG8_WAIT_V(8); PG8_WAIT_L(0); PG8_BAR; PG8_MMA(0, 0, At, B0); PG8_MMA(0, 1, At, B1); PG8_BAR; PG8_SCHED;
            PG8_LDA(At, 1, 1); PG8_STAGE(PG8_SB(1, 0), b3, voffB); PG8_STAGE(PG8_SB(1, 1), b3 + hstep, voffB); PG8_STAGE(PG8_SA(1, 0), a3, voffA);
            PG8_WAIT_V(8); PG8_WAIT_L(0); PG8_BAR; PG8_MMA(1, 0, At, B0); PG8_MMA(1, 1, At, B1); PG8_BAR; PG8_SCHED;
            } else {
            PG8_LDB(B0, 0, 0); PG8_SCHED; PG8_LDA(At, 0, 0); PG8_STAGE(PG8_SA(1, 1), a1 + hstep, voffA);
            PG8_WAIT_L(8); PG8_BAR; PG8_WAIT_L(0); PG8_MMA(0, 0, At, B0); PG8_BAR; PG8_SCHED;
            PG8_LDB(B1, 0, 1); PG8_STAGE(PG8_SB(0, 0), b2, voffB);
            PG8_BAR; PG8_WAIT_L(0); PG8_MMA(0, 1, At, B1); PG8_BAR;
            PG8_LDA(At, 0, 1); PG8_STAGE(PG8_SA(0, 0), a2, voffA);
            PG8_BAR; PG8_WAIT_L(0); PG8_MMA(1, 0, At, B0); PG8_BAR; PG8_SCHED;
            PG8_STAGE(PG8_SB(0, 1), b2 + hstep, voffB);
            PG8_WAIT_V(6); PG8_BAR; PG8_MMA(1, 1, At, B1); PG8_BAR;
            PG8_LDB(B0, 1, 0); PG8_SCHED; PG8_LDA(At, 1, 0); PG8_STAGE(PG8_SA(0, 1), a2 + hstep, voffA);
            PG8_WAIT_L(8); PG8_BAR; PG8_WAIT_L(0); PG8_MMA(0, 0, At, B0); PG8_BAR; PG8_SCHED;
            PG8_LDB(B1, 1, 1); PG8_STAGE(PG8_SB(1, 0), b3, voffB);
            PG8_BAR; PG8_WAIT_L(0); PG8_MMA(0, 1, At, B1); PG8_BAR;
            PG8_LDA(At, 1, 1); PG8_STAGE(PG8_SA(1, 0), a3, voffA);
            PG8_BAR; PG8_WAIT_L(0); PG8_MMA(1, 0, At, B0); PG8_BAR; PG8_SCHED;
            PG8_STAGE(PG8_SB(1, 1), b3 + hstep, voffB);
            PG8_WAIT_V(6); PG8_BAR; PG8_MMA(1, 1, At, B1); PG8_BAR;
            }
        }
        if constexpr (ALIGN_EPI) { if (wr == 0) PG8_BAR; }
        if constexpr (!Epi::AFTER_DRAIN) { E(acc, cur, wr, wc, fr, fq); S.done(cur); }
        if (!has_next) break;
#pragma unroll
        for (int a = 0; a < 2; ++a)
#pragma unroll
            for (int b = 0; b < 2; ++b)
#pragma unroll
                for (int m = 0; m < 4; ++m)
#pragma unroll
                    for (int n = 0; n < 2; ++n) acc[a][b][m][n] = (f32x4){0.f, 0.f, 0.f, 0.f};
        cur = nxt; cA = nA; cB = nB; ++ui;
        if constexpr (ALIGN_EPI) { if (wr == 1) PG8_BAR; }
    }
    PG8_WAIT_V(0);
    if constexpr (!ALIGN_EPI) { if (wr == 0) PG8_BAR; }
    PG8_BAR;
    if constexpr (Epi::AFTER_DRAIN) { E.fused(acc, cur, wr, wc, fr, fq, lds, wid, lane); S.done(cur); }
#undef PG8_SA
#undef PG8_SB
#undef PG8_STAGE
#undef PG8_LDA
#undef PG8_LDB
#undef PG8_MMA
#undef PG8_WAIT_V
#undef PG8_WAIT_L
#undef PG8_BAR
#undef PG8_SCHED
}
}

using pg8::bf16_t; using pg8::bf16x8; using pg8::f32x4; using pg8::u32x4; using pg8::Unit;
typedef __bf16 bf16x2_t __attribute__((ext_vector_type(2)));
typedef float f32x2_t __attribute__((ext_vector_type(2)));
__device__ __forceinline__ unsigned cvt_pk_bf16(float lo, float hi) { const f32x2_t v = {lo, hi}; const bf16x2_t b = __builtin_convertvector(v, bf16x2_t); return __builtin_bit_cast(unsigned, b); }
typedef short s16x4 __attribute__((ext_vector_type(4)));
typedef unsigned u32x2 __attribute__((ext_vector_type(2)));
#define LAS __attribute__((address_space(3)))
constexpr int DM = 1024, DEPTH = 4, DFF = 2816, ZN = 6912, INC = 6784;
constexpr int MC = 32768;
constexpr int NCHUNK = 3;
constexpr int NQKH = 28, QKP = NQKH * 64;
constexpr float LOG2E = 1.4426950408889634f;
constexpr int LUTN = 8192, LUTOFF = 4096;
constexpr size_t MiB = 1u << 20;
constexpr size_t WS_LUT = 0, WS_GT = 512 * 1024, WS_PT = 768 * 1024, WS_W = 1 * MiB, WL = 35 * MiB;
constexpr size_t W_IN = 0, W_PA = 14155776, W_PB = 15204352, W_PC = 15990784, W_O = 17039360, W_GU = 19136512, W_DN = 30670848, W_SGU = 36438016;
static_assert(W_SGU + 8 * 128 * 128 * 2 == WL, "weight map");
constexpr size_t WS_XB = 141 * MiB, WS_ZU = 205 * MiB, WS_ZV = 237 * MiB, WS_QK = 269 * MiB, WS_VTB = 381 * MiB, WS_VTC = 405 * MiB, WS_GATE = 437 * MiB;
constexpr size_t WS_AOUT = 629 * MiB, WS_BOUT = 661 * MiB, WS_COUT = 685 * MiB, WS_MERGED = 717 * MiB, WS_SS1 = 781 * MiB, WS_SS2 = 783 * MiB, WS_LB = 785 * MiB, WS_XB2 = 786 * MiB, WS_END = 850 * MiB;
constexpr size_t WS_MF32 = WS_QK, WS_HID = WS_GATE;
static_assert(WS_W + 4 * WL == WS_XB && WS_QK + (size_t)MC * QKP * 2 == WS_VTB && WS_VTB + (size_t)MC * 384 * 2 == WS_VTC && WS_VTC + (size_t)MC * 512 * 2 == WS_GATE, "ws map");
static_assert(WS_MF32 + (size_t)MC * 1024 * 4 <= WS_GATE && WS_HID + (size_t)MC * DFF * 2 <= WS_AOUT && WS_GATE + (size_t)MC * 3072 * 2 == WS_AOUT, "ws alias map");
constexpr int PT_L = 4096, PT_SUBG = 0, PT_LNG = 128, PT_LNB = 640, PT_SGUB = 1152, PT_LAM = 2176;
constexpr int LDS_BYTES = 147456;
constexpr int NSTEPS = 1 + NCHUNK * DEPTH * 6;

struct Args { const float* in[25]; float* out; unsigned char* ws; int lo, hi; };
enum { I_XP = 0, I_XS, I_RELB, I_N1G, I_WIN, I_LNG, I_LNB, I_SGUW, I_SGUB, I_QNB, I_KNB, I_QNC, I_KNC, I_LQ1, I_LK1, I_LQ2, I_LK2, I_SUBG, I_WPA, I_WPB, I_WPC, I_WO, I_N2G, I_WGU, I_WDN };

__device__ __forceinline__ float bflo(unsigned w) { return __uint_as_float(w << 16); }
__device__ __forceinline__ float bfhi(unsigned w) { return __uint_as_float(w & 0xffff0000u); }
__device__ __forceinline__ float fexp2(float x) { return __builtin_amdgcn_exp2f(x); }
__device__ __forceinline__ float frcp(float x) { return __builtin_amdgcn_rcpf(x); }
__device__ __forceinline__ float sigmoidf_(float x) { return frcp(1.f + fexp2(-LOG2E * x)); }
__device__ __forceinline__ float gelu_tanh(float x) { const float u = 0.7978845608028654f * (x + 0.044715f * x * x * x); return x * frcp(1.f + fexp2(-2.f * LOG2E * u)); }
__device__ __forceinline__ float shx(float v, int lane, int o) { return __builtin_bit_cast(float, __builtin_amdgcn_ds_bpermute((lane ^ o) << 2, __builtin_bit_cast(int, v))); }
__device__ __forceinline__ float wave_sum(float v, int lane) {
#pragma unroll
    for (int o = 1; o < 64; o <<= 1) v += shx(v, lane, o);
    return v;
}
__device__ __forceinline__ float quad_sum(float v, int lane) { v += shx(v, lane, 16); v += shx(v, lane, 32); return v; }
__device__ __forceinline__ unsigned cvt_pk_asm(float lo, float hi) { unsigned r; asm volatile("s_nop 1\n\tv_cvt_pk_bf16_f32 %0, %1, %2" : "=v"(r) : "v"(lo), "v"(hi)); return r; }
__device__ __forceinline__ u32x4 pack8(const float* v) { u32x4 w; w.x = cvt_pk_asm(v[0], v[1]); w.y = cvt_pk_asm(v[2], v[3]); w.z = cvt_pk_asm(v[4], v[5]); w.w = cvt_pk_asm(v[6], v[7]); return w; }
__device__ __forceinline__ float ss_total(const float* ssp, size_t row) {
    float t = 0.f;
#pragma unroll
    for (int pn = 0; pn < 4; ++pn) { const f32x4 v = *(const f32x4*)(ssp + ((size_t)pn * MC + row) * 4); t += (v[0] + v[1]) + (v[2] + v[3]); }
    return t;
}
__device__ __forceinline__ void unit_row_scales(float (&rs)[2][4], const float* ssp, LAS float* rsb, int pm, int wr, int wc, int fr, int fq) {
    const int t = (wr * 4 + wc) * 64 + fq * 16 + fr;
    if (t < 256) rsb[t] = rsqrtf(ss_total(ssp, (size_t)pm * 256 + t) * (1.f / 1024.f) + 1e-6f);
    asm volatile("s_waitcnt lgkmcnt(0)" ::: "memory"); __builtin_amdgcn_s_barrier(); asm volatile("" ::: "memory");
#pragma unroll
    for (int ai = 0; ai < 2; ++ai)
#pragma unroll
        for (int m = 0; m < 4; ++m) rs[ai][m] = rsb[ai * 128 + wr * 64 + m * 16 + fr];
}
#define MFMA16(a, b, c) __builtin_amdgcn_mfma_f32_16x16x32_bf16((a), (b), (c), 0, 0, 0)

struct EpiWin {
    static constexpr bool PERM = true, AFTER_DRAIN = false;
    unsigned char* ws; int l, lgS; LAS float* rsb;
    __device__ __forceinline__ void operator()(const f32x4 (&acc)[2][2][4][2], const Unit& u, int wr, int wc, int fr, int fq) const {
        const int row0 = u.pm * 256 + wr * 64 + fr, pn = u.pn;
        const float* ss1 = (const float*)(ws + WS_SS1);
        float rs[2][4];
        unit_row_scales(rs, ss1, rsb, u.pm, wr, wc, fr, fq);
        if (pn < 4) {
            bf16_t* base = (bf16_t*)(ws + (pn < 2 ? WS_ZU : WS_ZV)) + (pn & 1) * 256 + wc * 32 + 8 * fq;
#pragma unroll
            for (int ai = 0; ai < 2; ++ai)
#pragma unroll
                for (int m = 0; m < 4; ++m) { const size_t row = row0 + ai * 128 + m * 16;
#pragma unroll
                    for (int bj = 0; bj < 2; ++bj) { float v[8];
#pragma unroll
                        for (int e = 0; e < 8; ++e) v[e] = gelu_tanh(acc[ai][bj][m][e >> 2][e & 3] * rs[ai][m]);
                        *(u32x4*)(base + row * 512 + bj * 128) = pack8(v); } __builtin_amdgcn_sched_barrier(0); }
        } else if (pn < 11) {
            const int hh = 4 * (pn - 4) + wc;
            const float* gp = (const float*)(ws + WS_GT) + (l * NQKH + hh) * 64;
            float g[2][8];
#pragma unroll
            for (int bj = 0; bj < 2; ++bj)
#pragma unroll
                for (int e = 0; e < 8; ++e) g[bj][e] = gp[32 * bj + 8 * fq + e];
            bf16_t* base = (bf16_t*)(ws + WS_QK) + hh * 64 + 8 * fq;
#pragma unroll
            for (int ai = 0; ai < 2; ++ai)
#pragma unroll
                for (int m = 0; m < 4; ++m) { const int rown = row0 + ai * 128 + m * 16; float ssq = 0.f;
                    size_t row = rown;
                    if (hh < 12) { const int lgd = 2 * ((hh < 6 ? hh : hh - 6) >> 1), s = rown & ((1 << lgS) - 1), nn = s >> lgd; row = (size_t)(rown - s) + ((((nn >> 4) << lgd) + (s & ((1 << lgd) - 1))) << 4) + (nn & 15); }
#pragma unroll
                    for (int bj = 0; bj < 2; ++bj)
#pragma unroll
                        for (int e = 0; e < 8; ++e) { const float t = acc[ai][bj][m][e >> 2][e & 3] * rs[ai][m]; ssq += t * t; }
                    ssq = quad_sum(ssq, fq * 16 + fr);
                    const float r = rsqrtf(ssq * (1.f / 64.f) + 1e-6f) * rs[ai][m];
#pragma unroll
                    for (int bj = 0; bj < 2; ++bj) { float v[8];
#pragma unroll
                        for (int e = 0; e < 8; ++e) v[e] = acc[ai][bj][m][e >> 2][e & 3] * r * g[bj][e];
                        *(u32x4*)(base + row * QKP + 32 * bj) = pack8(v); } __builtin_amdgcn_sched_barrier(0); }
        } else if (pn < 15) {
            const int S = 1 << lgS;
#pragma unroll
            for (int bj = 0; bj < 2; ++bj) {
                const int vch0 = (pn - 11) * 256 + 128 * bj + 32 * wc + 8 * fq;
                if (vch0 >= 896) continue;
                const bool isB = vch0 < 384; const int lg = isB ? 2 * (vch0 >> 7) : 0;
#pragma unroll
                for (int ai = 0; ai < 2; ++ai)
#pragma unroll
                    for (int m = 0; m < 4; ++m) { const int row = row0 + ai * 128 + m * 16; const int b = row >> lgS, s = row & (S - 1);
                        const int nn = s >> lg, idx = ((((nn >> 4) << lg) + (s & ((1 << lg) - 1))) << 4) + (nn & 15);
                        bf16_t* dst = isB ? (bf16_t*)(ws + WS_VTB) + ((size_t)(b * 384 + vch0) << lgS) + idx : (bf16_t*)(ws + WS_VTC) + ((size_t)(b * 512 + vch0 - 384) << lgS) + s;
#pragma unroll
                        for (int e = 0; e < 8; e += 2) { const unsigned w = cvt_pk_asm(acc[ai][bj][m][e >> 2][e & 3] * rs[ai][m], acc[ai][bj][m][e >> 2][(e & 3) + 1] * rs[ai][m]);
                            dst[(size_t)e << lgS] = (bf16_t)(w & 0xffffu); dst[(size_t)(e + 1) << lgS] = (bf16_t)(w >> 16); } __builtin_amdgcn_sched_barrier(0); }
            }
        } else {
            bf16_t* base = (bf16_t*)(ws + WS_GATE) + (pn - 15) * 256 + wc * 32 + 8 * fq;
#pragma unroll
            for (int ai = 0; ai < 2; ++ai)
#pragma unroll
                for (int m = 0; m < 4; ++m) { const size_t row = row0 + ai * 128 + m * 16;
#pragma unroll
                    for (int bj = 0; bj < 2; ++bj) { float v[8];
#pragma unroll
                        for (int e = 0; e < 8; ++e) v[e] = sigmoidf_(acc[ai][bj][m][e >> 2][e & 3] * rs[ai][m]);
                        *(u32x4*)(base + row * 3072 + bj * 128) = pack8(v); } __builtin_amdgcn_sched_barrier(0); }
        }
    }
};
struct EpiWp {
    static constexpr bool PERM = true, AFTER_DRAIN = false;
    unsigned char* ws; int BR;
    __device__ __forceinline__ void operator()(const f32x4 (&acc)[2][2][4][2], const Unit& u, int wr, int wc, int fr, int fq) const {
        const int row0 = u.pm * 256 + wr * 64 + fr, col0 = u.pn * 256 + wc * 32 + 8 * fq;
        const bf16_t* gate = (const bf16_t*)(ws + WS_GATE); bf16_t* merged = (bf16_t*)(ws + WS_MERGED);
#pragma unroll
        for (int ai = 0; ai < 2; ++ai)
#pragma unroll
            for (int m = 0; m < 4; ++m) { const size_t row = row0 + ai * 128 + m * 16;
#pragma unroll
                for (int bj = 0; bj < 2; ++bj) { const int col = col0 + bj * 128;
                    const u32x4 gw = *(const u32x4*)(gate + row * 3072 + BR * 1024 + col);
                    float v[8];
                    v[0] = bflo(gw.x) * acc[ai][bj][m][0][0]; v[1] = bfhi(gw.x) * acc[ai][bj][m][0][1]; v[2] = bflo(gw.y) * acc[ai][bj][m][0][2]; v[3] = bfhi(gw.y) * acc[ai][bj][m][0][3];
                    v[4] = bflo(gw.z) * acc[ai][bj][m][1][0]; v[5] = bfhi(gw.z) * acc[ai][bj][m][1][1]; v[6] = bflo(gw.w) * acc[ai][bj][m][1][2]; v[7] = bfhi(gw.w) * acc[ai][bj][m][1][3];
                    bf16_t* mp = merged + row * 1024 + col;
                    if (BR > 0) { const u32x4 pm = *(const u32x4*)mp;
                        v[0] += bflo(pm.x); v[1] += bfhi(pm.x); v[2] += bflo(pm.y); v[3] += bfhi(pm.y); v[4] += bflo(pm.z); v[5] += bfhi(pm.z); v[6] += bflo(pm.w); v[7] += bfhi(pm.w); }
                    *(u32x4*)mp = pack8(v); } }
    }
};
struct EpiRes {
    static constexpr bool PERM = true, AFTER_DRAIN = false;
    float* xout; bf16_t* xb; float* ss; int next;
    __device__ __forceinline__ void operator()(const f32x4 (&acc)[2][2][4][2], const Unit& u, int wr, int wc, int fr, int fq) const {
        const int row0 = u.pm * 256 + wr * 64 + fr, col0 = u.pn * 256 + wc * 32 + 8 * fq;
#pragma unroll
        for (int ai = 0; ai < 2; ++ai)
#pragma unroll
            for (int m = 0; m < 4; ++m) { const size_t row = row0 + ai * 128 + m * 16; float part = 0.f;
#pragma unroll
                for (int bj = 0; bj < 2; ++bj) { const int col = col0 + bj * 128;
                    const u32x4 xw = *(const u32x4*)(xb + row * 1024 + col);
                    float v[8];
                    v[0] = bflo(xw.x) + acc[ai][bj][m][0][0]; v[1] = bfhi(xw.x) + acc[ai][bj][m][0][1]; v[2] = bflo(xw.y) + acc[ai][bj][m][0][2]; v[3] = bfhi(xw.y) + acc[ai][bj][m][0][3];
                    v[4] = bflo(xw.z) + acc[ai][bj][m][1][0]; v[5] = bfhi(xw.z) + acc[ai][bj][m][1][1]; v[6] = bflo(xw.w) + acc[ai][bj][m][1][2]; v[7] = bfhi(xw.w) + acc[ai][bj][m][1][3];
                    if (next) { *(u32x4*)(xb + row * 1024 + col) = pack8(v);
#pragma unroll
                        for (int e = 0; e < 8; ++e) part += v[e] * v[e]; }
                    else { *(f32x4*)(xout + row * 1024 + col) = (f32x4){v[0], v[1], v[2], v[3]}; *(f32x4*)(xout + row * 1024 + col + 4) = (f32x4){v[4], v[5], v[6], v[7]}; } }
                if (next) { part = quad_sum(part, fq * 16 + fr); if (fq == 0) ss[((size_t)u.pn * MC + row) * 4 + wc] = part; } }
    }
};
struct EpiGu {
    static constexpr bool PERM = true, AFTER_DRAIN = false;
    const float* ss2; bf16_t* hid; LAS float* rsb;
    __device__ __forceinline__ void operator()(const f32x4 (&acc)[2][2][4][2], const Unit& u, int wr, int wc, int fr, int fq) const {
        const int row0 = u.pm * 256 + wr * 64 + fr, col0 = u.pn * 128 + wc * 32 + 8 * fq;
        float rsv[2][4];
        unit_row_scales(rsv, ss2, rsb, u.pm, wr, wc, fr, fq);
#pragma unroll
        for (int ai = 0; ai < 2; ++ai)
#pragma unroll
            for (int m = 0; m < 4; ++m) { const size_t row = row0 + ai * 128 + m * 16;
                const float rs = rsv[ai][m]; float v[8];
#pragma unroll
                for (int e = 0; e < 8; ++e) { const float g = acc[ai][0][m][e >> 2][e & 3] * rs, uu = acc[ai][1][m][e >> 2][e & 3] * rs; v[e] = g * sigmoidf_(g) * uu; }
                *(u32x4*)(hid + row * DFF + col0) = pack8(v); }
    }
};

__device__ __forceinline__ int win_src(int n) {
    const int t = n >> 8, w = n & 255;
    if (t < 4) return n;
    if (t < 11) { const int hh = 4 * (t - 4) + ((w & 127) >> 5), d = (w >> 7) * 32;
        const int base = hh < 6 ? 1024 + hh * 64 : hh < 12 ? 1408 + (hh - 6) * 64 : hh < 20 ? 2176 + (hh - 12) * 64 : 2688 + (hh - 20) * 64; return base + d; }
    if (t < 15) { const int v = (t - 11) * 256 + w; return v < 384 ? 1792 + v : v < 896 ? 3200 + (v - 384) : -1; }
    return 3712 + (t - 15) * 256 + w;
}
__device__ __forceinline__ int wgu_src(int n) { const int t = n >> 8, w = n & 255; return w < 128 ? t * 128 + w : DFF + t * 128 + (w - 128); }
__device__ __forceinline__ void cvt_item(const float* W, int K, int N, bf16_t* WT, const float* rscale, int src0, int n0, int k0, LAS float* scr, int lane) {
    if (src0 < 0) {
        const int c = lane & 7;
#pragma unroll
        for (int j = 0; j < 4; ++j) { const int n = (lane >> 3) + 8 * j; *(u32x4*)(WT + (size_t)(n0 + n) * K + k0 + 8 * c) = (u32x4){0u, 0u, 0u, 0u}; }
        return;
    }
#pragma unroll 8
    for (int i = 0; i < 32; ++i) { const int kk = 2 * i + (lane >> 5); float v = W[(size_t)(k0 + kk) * N + src0 + (lane & 31)]; if (rscale) v *= rscale[k0 + kk]; scr[kk * 33 + (lane & 31)] = v; }
    asm volatile("s_waitcnt lgkmcnt(0)" ::: "memory");
    const int c = lane & 7;
#pragma unroll
    for (int j = 0; j < 4; ++j) { const int n = (lane >> 3) + 8 * j; const LAS float* s = scr + (8 * c) * 33 + n;
        u32x4 o; o.x = cvt_pk_bf16(s[0 * 33], s[1 * 33]); o.y = cvt_pk_bf16(s[2 * 33], s[3 * 33]); o.z = cvt_pk_bf16(s[4 * 33], s[5 * 33]); o.w = cvt_pk_bf16(s[6 * 33], s[7 * 33]);
        *(u32x4*)(WT + (size_t)(n0 + n) * K + k0 + 8 * c) = o; }
    asm volatile("s_waitcnt lgkmcnt(0)" ::: "memory");
}
__device__ __forceinline__ int rel_bucket(int rel) {
    const int n = rel < 0 ? -rel : rel; int b;
    if (n < 8) b = n; else b = 8 + (n >= 15) + (n >= 27) + (n >= 50) + (n >= 91) + (n >= 166) + (n >= 305) + (n >= 559);
    return b + (rel > 0 ? 16 : 0);
}
__device__ __forceinline__ void prep_chunk(const float* x, bf16_t* xb, float* ss1, int gw, int ngw, int lane) {
    for (int r0 = gw * 16; r0 < MC; r0 += ngw * 16) {
        float mine = 0.f;
        for (int k = 0; k < 16; ++k) { const int r = r0 + k;
            const f32x4* xr = (const f32x4*)(x + (size_t)r * 1024) + lane; float s = 0.f; f32x4 v[4];
#pragma unroll
            for (int j = 0; j < 4; ++j) { v[j] = xr[64 * j]; s += (v[j][0] * v[j][0] + v[j][1] * v[j][1]) + (v[j][2] * v[j][2] + v[j][3] * v[j][3]); }
            s = wave_sum(s, lane);
            u32x2* o = (u32x2*)(xb + (size_t)r * 1024) + lane;
#pragma unroll
            for (int j = 0; j < 4; ++j) o[64 * j] = (u32x2){cvt_pk_bf16(v[j][0], v[j][1]), cvt_pk_bf16(v[j][2], v[j][3])};
            if (lane == k) mine = s; }
        if (lane < 16) {
#pragma unroll
            for (int pn = 0; pn < 4; ++pn) *(f32x4*)(ss1 + ((size_t)pn * MC + r0 + lane) * 4) = (f32x4){pn == 0 ? mine : 0.f, 0.f, 0.f, 0.f}; }
    }
}
__device__ __forceinline__ void prologue(const Args& a, unsigned char* ws, LAS unsigned char* lds, int gw, int ngw, int wave, int lane) {
    LAS float* scr = (LAS float*)(lds + wave * 8448);
    constexpr int I0 = 3456, I1 = I0 + 256, I2 = I1 + 192, I3 = I2 + 256, I4 = I3 + 512, I5 = I4 + 2816, I6 = I5 + 1408;
    for (int it = gw; it < DEPTH * I6; it += ngw) {
        const int l = it / I6; int r = it % I6; unsigned char* wl = ws + WS_W + (size_t)l * WL;
        if (r < I0) { const int kb = r / 216, nb = r % 216; cvt_item(a.in[I_WIN] + (size_t)l * 1024 * INC, 1024, INC, (bf16_t*)(wl + W_IN), a.in[I_N1G] + l * 1024, win_src(nb * 32), nb * 32, kb * 64, scr, lane); continue; }
        if (r < I1) { r -= I0; const int kb = r / 32, nb = r % 32; cvt_item(a.in[I_WPA] + (size_t)l * 512 * 1024, 512, 1024, (bf16_t*)(wl + W_PA), nullptr, nb * 32, nb * 32, kb * 64, scr, lane); continue; }
        if (r < I2) { r -= I1; const int kb = r / 32, nb = r % 32; cvt_item(a.in[I_WPB] + (size_t)l * 384 * 1024, 384, 1024, (bf16_t*)(wl + W_PB), nullptr, nb * 32, nb * 32, kb * 64, scr, lane); continue; }
        if (r < I3) { r -= I2; const int kb = r / 32, nb = r % 32; cvt_item(a.in[I_WPC] + (size_t)l * 512 * 1024, 512, 1024, (bf16_t*)(wl + W_PC), nullptr, nb * 32, nb * 32, kb * 64, scr, lane); continue; }
        if (r < I4) { r -= I3; const int kb = r / 32, nb = r % 32; cvt_item(a.in[I_WO] + (size_t)l * 1024 * 1024, 1024, 1024, (bf16_t*)(wl + W_O), nullptr, nb * 32, nb * 32, kb * 64, scr, lane); continue; }
        if (r < I5) { r -= I4; const int kb = r / 176, nb = r % 176; cvt_item(a.in[I_WGU] + (size_t)l * 1024 * 2 * DFF, 1024, 2 * DFF, (bf16_t*)(wl + W_GU), a.in[I_N2G] + l * 1024, wgu_src(nb * 32), nb * 32, kb * 64, scr, lane); continue; }
        { r -= I5; const int kb = r / 32, nb = r % 32; cvt_item(a.in[I_WDN] + (size_t)l * DFF * 1024, DFF, 1024, (bf16_t*)(wl + W_DN), nullptr, nb * 32, nb * 32, kb * 64, scr, lane); }
    }
    for (int i = gw * 64 + lane; i < DEPTH * 8 * 128 * 128 / 8; i += ngw * 64) {
        const int l = i / (8 * 128 * 128 / 8), r = i % (8 * 128 * 128 / 8);
        const f32x4 p = *(const f32x4*)(a.in[I_SGUW] + (size_t)i * 8), q = *(const f32x4*)(a.in[I_SGUW] + (size_t)i * 8 + 4);
        *(u32x4*)((bf16_t*)(ws + WS_W + (size_t)l * WL + W_SGU) + (size_t)r * 8) = (u32x4){cvt_pk_bf16(p[0], p[1]), cvt_pk_bf16(p[2], p[3]), cvt_pk_bf16(q[0], q[1]), cvt_pk_bf16(q[2], q[3])};
    }
    float* lut = (float*)(ws + WS_LUT);
    for (int i = gw * 64 + lane; i < 10 * LUTN; i += ngw * 64) { const int h = i / LUTN, rel = (i % LUTN) - LUTOFF; lut[i] = a.in[I_RELB][rel_bucket(rel) * 10 + h] * LOG2E; }
    float* pt = (float*)(ws + WS_PT);
    for (int i = gw * 64 + lane; i < DEPTH * 2176; i += ngw * 64) { const int l = i / 2176, r = i % 2176;
        pt[l * PT_L + r] = r < 128 ? a.in[I_SUBG][l * 128 + r] : r < 640 ? a.in[I_LNG][l * 512 + r - 128] : r < 1152 ? a.in[I_LNB][l * 512 + r - 640] : a.in[I_SGUB][l * 1024 + r - 1152]; }
    if (gw < DEPTH) { const int l = gw;
        const float s1 = wave_sum(a.in[I_LQ1][l * 64 + lane] * a.in[I_LK1][l * 64 + lane], lane), s2 = wave_sum(a.in[I_LQ2][l * 64 + lane] * a.in[I_LK2][l * 64 + lane], lane);
        const float lam_init = 0.8f - 0.6f * expf(-0.3f * (float)l);
        if (lane == 0) { pt[l * PT_L + PT_LAM] = expf(s1) - expf(s2) + lam_init; pt[l * PT_L + PT_LAM + 1] = lam_init; } }
    float* gt = (float*)(ws + WS_GT);
    for (int i = gw * 64 + lane; i < DEPTH * NQKH * 64; i += ngw * 64) { const int l = i / (NQKH * 64), hh = (i / 64) % NQKH, d = i % 64;
        const float* gp = hh < 6 ? a.in[I_QNB] : hh < 12 ? a.in[I_KNB] : hh < 20 ? a.in[I_QNC] : a.in[I_KNC];
        gt[i] = gp[l * 64 + d] * ((hh < 6 || (hh >= 12 && hh < 20)) ? 0.125f * LOG2E : 1.f); }
    prep_chunk(a.in[I_XP], (bf16_t*)(ws + WS_XB), (float*)(ws + WS_SS1), gw, ngw, lane);
}

constexpr int DA_KB = 16384, DA_STG = 32768;
__device__ __forceinline__ void diffattn_item(unsigned char* ws, LAS unsigned char* lds, int l, int lgS, int b, int h, int qb, int tid, int wave, int lane) {
    const int S = 1 << lgS, T = S >> 6;
    LAS float* lut = (LAS float*)lds;
    LAS unsigned char* stg = lds + 32768;
    const int ql = lane & 15, quad = lane >> 4, q0 = qb * 128 + wave * 16;
    const bf16_t* qkb = (const bf16_t*)(ws + WS_QK) + ((size_t)b << lgS) * QKP;
    const bf16_t* kg[2]; const bf16_t* vg[2];
#pragma unroll
    for (int i = 0; i < 2; ++i) { const int P = (i * 8 + wave) * 64 + lane, key = P >> 4, seg = (P & 15) ^ (key & 15), e = P >> 3, part = (P & 7) ^ ((e >> 1) & 7);
        kg[i] = qkb + (size_t)key * QKP + (20 + (seg >> 3) * 4 + h) * 64 + (seg & 7) * 8;
        vg[i] = (const bf16_t*)(ws + WS_VTC) + ((size_t)(b * 512 + h * 128 + e) << lgS) + part * 8; }
#define DA_DMA(tt, sidx) do { _Pragma("unroll") for (int i = 0; i < 2; ++i) { \
        __builtin_amdgcn_global_load_lds((const unsigned*)(kg[i] + (size_t)(tt) * 64 * QKP), (LAS unsigned*)(stg + (sidx) * DA_STG + (i * 8 + wave) * 1024), 16, 0, 0); \
        __builtin_amdgcn_global_load_lds((const unsigned*)(vg[i] + (tt) * 64), (LAS unsigned*)(stg + (sidx) * DA_STG + DA_KB + (i * 8 + wave) * 1024), 16, 0, 0); } } while (0)
    DA_DMA(0, 0); DA_DMA(1, 1);
    { const float* glut = (const float*)(ws + WS_LUT) + (6 + h) * LUTN;
      for (int i = tid; i < LUTN; i += 512) lut[i] = glut[i]; }
    bf16x8 qf[2][2];
#pragma unroll
    for (int c = 0; c < 2; ++c)
#pragma unroll
        for (int ks = 0; ks < 2; ++ks) qf[c][ks] = *(const bf16x8*)(qkb + (size_t)(q0 + ql) * QKP + (12 + c * 4 + h) * 64 + 32 * ks + 8 * quad);
    f32x4 o[2][8];
#pragma unroll
    for (int c = 0; c < 2; ++c)
#pragma unroll
        for (int dt = 0; dt < 8; ++dt) o[c][dt] = (f32x4){0.f, 0.f, 0.f, 0.f};
    float lsum0 = 0.f, lsum1 = 0.f;
    const LAS float* lutq = lut + LUTOFF - (q0 + ql) + 4 * quad;
    int kfo[2][2], vfo[2][2];
#pragma unroll
    for (int c = 0; c < 2; ++c)
#pragma unroll
        for (int ks = 0; ks < 2; ++ks) kfo[c][ks] = ql * 256 + (((c * 8 + ks * 4 + quad) ^ ql) << 4);
#pragma unroll
    for (int hf = 0; hf < 2; ++hf)
#pragma unroll
        for (int x = 0; x < 2; ++x) vfo[hf][x] = DA_KB + ql * 128 + (((4 * hf + (quad >> 1) + 2 * x) ^ ((ql >> 1) & 7)) << 4) + 8 * (quad & 1);
    asm volatile("s_waitcnt vmcnt(4) lgkmcnt(0)" ::: "memory"); __builtin_amdgcn_s_barrier(); asm volatile("" ::: "memory");
#define DA_LDK(sbp, hf_) do { _Pragma("unroll") for (int kt = 0; kt < 2; ++kt) _Pragma("unroll") for (int c = 0; c < 2; ++c) _Pragma("unroll") for (int ks = 0; ks < 2; ++ks) \
        kf[kt][c][ks] = *(const LAS bf16x8*)((sbp) + (32 * (hf_) + 16 * kt) * 256 + kfo[c][ks]); } while (0)
#define DA_LDB(k0_) do { _Pragma("unroll") for (int kt = 0; kt < 2; ++kt) _Pragma("unroll") for (int j = 0; j < 4; ++j) biasv[kt][j] = lutq[(k0_) + 16 * kt + j]; } while (0)
    bf16x8 kf[2][2][2]; f32x4 biasv[2];
    DA_LDK(stg, 0); DA_LDB(0);
    int s0 = 0;
    for (int t = 0; t < T; ++t) {
        const int s1 = s0 == 2 ? 0 : s0 + 1, s2 = s1 == 2 ? 0 : s1 + 1;
        if (t + 2 < T) DA_DMA(t + 2, s2);
        const LAS unsigned char* sb = stg + s0 * DA_STG;
#pragma unroll
        for (int hf = 0; hf < 2; ++hf) {
            f32x4 st[2][2];
#pragma unroll
            for (int kt = 0; kt < 2; ++kt)
#pragma unroll
                for (int c = 0; c < 2; ++c) { f32x4 z = MFMA16(kf[kt][c][0], qf[c][0], biasv[kt]); st[c][kt] = MFMA16(kf[kt][c][1], qf[c][1], z); }
            __builtin_amdgcn_sched_barrier(0);
            s16x4 v0[4], v1[4], w0[4], w1[4];
#pragma unroll
            for (int dt = 0; dt < 4; ++dt) { v0[dt] = *(const LAS s16x4*)(sb + dt * 2048 + vfo[hf][0]); v1[dt] = *(const LAS s16x4*)(sb + dt * 2048 + vfo[hf][1]); }
            if (hf == 0) DA_LDK(sb, 1);
            __builtin_amdgcn_sched_barrier(0);
#pragma unroll
            for (int kt = 0; kt < 2; ++kt)
#pragma unroll
                for (int j = 0; j < 4; ++j) { const float p0 = fexp2(st[0][kt][j]), p1 = fexp2(st[1][kt][j]); lsum0 += p0; lsum1 += p1; st[0][kt][j] = p0; st[1][kt][j] = p1; }
            bf16x8 pf[2];
#pragma unroll
            for (int c = 0; c < 2; ++c) { u32x4 w; w.x = cvt_pk_bf16(st[c][0][0], st[c][0][1]); w.y = cvt_pk_bf16(st[c][0][2], st[c][0][3]); w.z = cvt_pk_bf16(st[c][1][0], st[c][1][1]); w.w = cvt_pk_bf16(st[c][1][2], st[c][1][3]);
                pf[c] = __builtin_bit_cast(bf16x8, w); }
            __builtin_amdgcn_sched_barrier(0);
#pragma unroll
            for (int dt = 0; dt < 4; ++dt) { w0[dt] = *(const LAS s16x4*)(sb + (dt + 4) * 2048 + vfo[hf][0]); w1[dt] = *(const LAS s16x4*)(sb + (dt + 4) * 2048 + vfo[hf][1]); }
            if (hf == 0) DA_LDB(t * 64 + 32);
#pragma unroll
            for (int dt = 0; dt < 4; ++dt) { const bf16x8 vf = __builtin_shufflevector(v0[dt], v1[dt], 0, 1, 2, 3, 4, 5, 6, 7);
                o[0][dt] = MFMA16(vf, pf[0], o[0][dt]); o[1][dt] = MFMA16(vf, pf[1], o[1][dt]); }
            __builtin_amdgcn_sched_barrier(0);
#pragma unroll
            for (int dt = 0; dt < 4; ++dt) { const bf16x8 vf = __builtin_shufflevector(w0[dt], w1[dt], 0, 1, 2, 3, 4, 5, 6, 7);
                o[0][dt + 4] = MFMA16(vf, pf[0], o[0][dt + 4]); o[1][dt + 4] = MFMA16(vf, pf[1], o[1][dt + 4]); }
            __builtin_amdgcn_sched_barrier(0);
        }
        if (t + 2 < T) asm volatile("s_waitcnt vmcnt(4) lgkmcnt(0)" ::: "memory"); else asm volatile("s_waitcnt vmcnt(0) lgkmcnt(0)" ::: "memory");
        __builtin_amdgcn_s_barrier(); asm volatile("" ::: "memory");
        __builtin_amdgcn_sched_barrier(0);
        if (t + 1 < T) { DA_LDK(stg + s1 * DA_STG, 0); DA_LDB((t + 1) * 64); }
        s0 = s1;
    }
#undef DA_LDB
#undef DA_LDK
#undef DA_DMA
    lsum0 = quad_sum(lsum0, lane); lsum1 = quad_sum(lsum1, lane);
    const float* pt = (const float*)(ws + WS_PT) + l * PT_L;
    const float lam = pt[PT_LAM], lam_init = pt[PT_LAM + 1];
    const float i1 = 1.f / lsum0, i2 = lam / lsum1; float ssq = 0.f;
#pragma unroll
    for (int dt = 0; dt < 8; ++dt)
#pragma unroll
        for (int j = 0; j < 4; ++j) { const float v = o[0][dt][j] * i1 - o[1][dt][j] * i2; o[0][dt][j] = v; ssq += v * v; }
    ssq = quad_sum(ssq, lane);
    const float r = rsqrtf(ssq * (1.f / 128.f) + 1e-6f) * (1.f - lam_init);
    bf16_t* outp = (bf16_t*)(ws + WS_COUT) + ((size_t)(b << lgS) + q0 + ql) * 512 + h * 128 + 4 * quad;
    const float* sg = pt + PT_SUBG + 4 * quad;
#pragma unroll
    for (int dt = 0; dt < 8; ++dt) { const f32x4 g = *(const f32x4*)(sg + 16 * dt);
        *(u32x2*)(outp + 16 * dt) = (u32x2){cvt_pk_bf16(o[0][dt][0] * r * g[0], o[0][dt][1] * r * g[1]), cvt_pk_bf16(o[0][dt][2] * r * g[2], o[0][dt][3] * r * g[3])}; }
}

__device__ __forceinline__ void dilattn_item(unsigned char* ws, LAS unsigned char* lds, int lgS, int b, int sp, int j, int tid, int wave, int lane) {
    const int S = 1 << lgS;
    const int ql = lane & 15, quad = lane >> 4;
    const bf16_t* qkb = (const bf16_t*)(ws + WS_QK) + ((size_t)b << lgS) * QKP;
    bf16_t* bout = (bf16_t*)(ws + WS_BOUT) + ((size_t)b << lgS) * 384;
    float* lb = (float*)(ws + WS_LB) + ((size_t)j * MC + ((size_t)b << lgS)) * 4;
    const float* glut = (const float*)(ws + WS_LUT);
    LAS float* lutl = (LAS float*)lds;
#pragma unroll
    for (int i0 = 0; i0 < 3 * 4096; i0 += 512) { const int i = i0 + tid; lutl[i] = glut[(2 * (i >> 12) + j) * LUTN + LUTOFF - 2048 + (i & 4095)]; }
    __syncthreads();
    for (int uu = wave; uu < 48; uu += 8) {
        const int gi = uu >> 4, u = uu & 15, lg = 2 * gi, dil = 1 << lg, r = u & (dil - 1), n0 = (sp << (8 - lg)) + 16 * (u >> lg), L = S >> lg, hh = 2 * gi + j;
        const int tokq = ((n0 + ql) << lg) + r;
        bf16x8 qf[2];
#pragma unroll
        for (int ks = 0; ks < 2; ++ks) qf[ks] = *(const bf16x8*)(qkb + (size_t)(((((n0 >> 4) << lg) + r) << 4) + ql) * QKP + hh * 64 + 32 * ks + 8 * quad);
        f32x4 st[10];
#pragma unroll
        for (int kt = 0; kt < 10; ++kt) { int n = n0 - 64 + 32 * (kt >> 1) + 8 * (ql >> 2) + 4 * (kt & 1) + (ql & 3); n = n < 0 ? 0 : (n > L - 1 ? L - 1 : n);
            const bf16_t* kp = qkb + (size_t)(((((n >> 4) << lg) + r) << 4) + (n & 15)) * QKP + (6 + hh) * 64 + 8 * quad;
            const bf16x8 ka0 = *(const bf16x8*)kp, ka1 = *(const bf16x8*)(kp + 32);
            f32x4 z = (f32x4){0.f, 0.f, 0.f, 0.f}; z = MFMA16(ka0, qf[0], z); st[kt] = MFMA16(ka1, qf[1], z); }
        float lsum = 0.f;
        const LAS float* lutp = lutl + gi * 4096 + 2048;
#pragma unroll
        for (int kt = 0; kt < 10; ++kt)
#pragma unroll
            for (int e = 0; e < 4; ++e) { const int n = n0 - 64 + 32 * (kt >> 1) + 8 * quad + 4 * (kt & 1) + e, rel = n - (n0 + ql);
                const bool valid = (n >= 0) && (n < L) && (rel <= 64) && (rel >= -64);
                const float bias = lutp[rel * dil];
                const float p = valid ? fexp2(st[kt][e] + bias) : 0.f; lsum += p; st[kt][e] = p; }
        f32x4 o[4];
#pragma unroll
        for (int dt = 0; dt < 4; ++dt) o[dt] = (f32x4){0.f, 0.f, 0.f, 0.f};
        const bf16_t* vb = (const bf16_t*)(ws + WS_VTB) + ((size_t)(b * 384 + hh * 64 + ql) << lgS);
#pragma unroll
        for (int i = 0; i < 5; ++i) {
            u32x4 w; w.x = cvt_pk_bf16(st[2 * i][0], st[2 * i][1]); w.y = cvt_pk_bf16(st[2 * i][2], st[2 * i][3]); w.z = cvt_pk_bf16(st[2 * i + 1][0], st[2 * i + 1][1]); w.w = cvt_pk_bf16(st[2 * i + 1][2], st[2 * i + 1][3]);
            const bf16x8 pf = __builtin_bit_cast(bf16x8, w);
            int na = n0 - 64 + 32 * i + 8 * quad;
            na = na < 0 ? 0 : (na > L - 8 ? L - 8 : na);
#pragma unroll
            for (int dt = 0; dt < 4; ++dt) { const bf16_t* vp = vb + ((size_t)(dt * 16) << lgS);
                const bf16x8 vf = *(const bf16x8*)(vp + (((((na >> 4) << lg) + r) << 4) + (na & 15)));
                o[dt] = MFMA16(vf, pf, o[dt]); }
        }
        lsum = quad_sum(lsum, lane);
        bf16_t* op = bout + (size_t)tokq * 384 + hh * 64 + 4 * quad;
#pragma unroll
        for (int dt = 0; dt < 4; ++dt) *(u32x2*)(op + 16 * dt) = (u32x2){cvt_pk_bf16(o[dt][0], o[dt][1]), cvt_pk_bf16(o[dt][2], o[dt][3])};
        if (quad == 0) lb[(size_t)tokq * 4 + gi] = lsum;
    }
    asm volatile("s_waitcnt vmcnt(0)" ::: "memory"); __builtin_amdgcn_fence(__ATOMIC_SEQ_CST, "workgroup"); __syncthreads(); __builtin_amdgcn_fence(__ATOMIC_SEQ_CST, "workgroup");
    for (int idx = tid; idx < 256 * 24; idx += 512) {
        const int tok = sp * 256 + idx / 24, rem = idx % 24, gi = rem >> 3, piece = rem & 7, hh = 2 * gi + j;
        const float* lp = lb + (size_t)tok * 4;
        const float inv = 1.f / (lp[0] + lp[1] + lp[2]);
        u32x4* p = (u32x4*)(bout + (size_t)tok * 384 + hh * 64 + piece * 8); const u32x4 w = *p;
        u32x4 o; o.x = cvt_pk_bf16(bflo(w.x) * inv, bfhi(w.x) * inv); o.y = cvt_pk_bf16(bflo(w.y) * inv, bfhi(w.y) * inv); o.z = cvt_pk_bf16(bflo(w.z) * inv, bfhi(w.z) * inv); o.w = cvt_pk_bf16(bflo(w.w) * inv, bfhi(w.w) * inv);
        *p = o;
    }
    __syncthreads();
}

__device__ __forceinline__ void sgu_item(unsigned char* ws, LAS unsigned char* lds, int l, int ci, int tid, int wave, int lane) {
    const float* ptab = (const float*)(ws + WS_PT) + l * PT_L;
    typedef float f32x2 __attribute__((ext_vector_type(2)));
    LAS f32x2* stats = (LAS f32x2*)lds;
    LAS unsigned char* img = lds + 1024 + wave * 17408;
    const bf16_t* zv = (const bf16_t*)(ws + WS_ZV) + (size_t)ci * 128 * 512;
    const bf16_t* zu = (const bf16_t*)(ws + WS_ZU) + (size_t)ci * 128 * 512;
    bf16_t* aout = (bf16_t*)(ws + WS_AOUT) + (size_t)ci * 128 * 512;
#pragma unroll
    for (int t = 0; t < 16; ++t) { const int tok = wave * 16 + t;
        const u32x4 w = *(const u32x4*)(zv + (size_t)tok * 512 + lane * 8);
        float v[8] = {bflo(w.x), bfhi(w.x), bflo(w.y), bfhi(w.y), bflo(w.z), bfhi(w.z), bflo(w.w), bfhi(w.w)};
        float s = 0.f;
#pragma unroll
        for (int e = 0; e < 8; ++e) s += v[e];
        const float mean = wave_sum(s, lane) * (1.f / 512.f); float s2 = 0.f;
#pragma unroll
        for (int e = 0; e < 8; ++e) { const float d = v[e] - mean; s2 += d * d; }
        const float rstd = rsqrtf(wave_sum(s2, lane) * (1.f / 512.f) + 1e-5f);
        if (lane == 0) stats[tok] = (f32x2){mean, rstd}; }
    __syncthreads();
    const int g = wave;
    { const int tl = lane >> 3, cp = lane & 7; float gam[8], bet[8];
#pragma unroll
      for (int e = 0; e < 8; ++e) { gam[e] = ptab[PT_LNG + g * 64 + 8 * cp + e]; bet[e] = ptab[PT_LNB + g * 64 + 8 * cp + e]; }
#pragma unroll
      for (int it = 0; it < 16; ++it) { const int tok = 8 * it + tl; const f32x2 ms = stats[tok];
          const u32x4 w = *(const u32x4*)(zv + (size_t)tok * 512 + g * 64 + 8 * cp);
          float v[8] = {bflo(w.x), bfhi(w.x), bflo(w.y), bfhi(w.y), bflo(w.z), bfhi(w.z), bflo(w.w), bfhi(w.w)};
#pragma unroll
          for (int e = 0; e < 8; ++e) v[e] = (v[e] - ms[0]) * ms[1] * gam[e] + bet[e];
          LAS u32x2* d = (LAS u32x2*)(img + tok * 136 + cp * 16);
          d[0] = (u32x2){cvt_pk_bf16(v[0], v[1]), cvt_pk_bf16(v[2], v[3])}; d[1] = (u32x2){cvt_pk_bf16(v[4], v[5]), cvt_pk_bf16(v[6], v[7])}; } }
    __syncthreads();
    const int ql = lane & 15, quad = lane >> 4;
    typedef short v4i16_t __attribute__((ext_vector_type(4)));
    bf16x8 af[4][4];
#pragma unroll
    for (int dt = 0; dt < 4; ++dt)
#pragma unroll
        for (int ks = 0; ks < 4; ++ks) {
            const LAS unsigned char* p0 = img + (32 * ks + 8 * quad + (ql >> 2)) * 136 + 32 * dt + 8 * (ql & 3);
            const s16x4 t0 = __builtin_bit_cast(s16x4, __builtin_amdgcn_ds_read_tr16_b64_v4i16((LAS v4i16_t*)p0));
            const s16x4 t1 = __builtin_bit_cast(s16x4, __builtin_amdgcn_ds_read_tr16_b64_v4i16((LAS v4i16_t*)(p0 + 4 * 136)));
            af[dt][ks] = __builtin_shufflevector(t0, t1, 0, 1, 2, 3, 4, 5, 6, 7); }
    const bf16_t* wg = (const bf16_t*)(ws + WS_W + (size_t)l * WL + W_SGU) + (size_t)g * 128 * 128;
#pragma unroll 2
    for (int pt = 0; pt < 8; ++pt) {
        f32x4 acc[4];
#pragma unroll
        for (int dt = 0; dt < 4; ++dt) acc[dt] = (f32x4){0.f, 0.f, 0.f, 0.f};
#pragma unroll
        for (int ks = 0; ks < 4; ++ks) { const bf16x8 bfr = *(const bf16x8*)(wg + (size_t)(16 * pt + ql) * 128 + 32 * ks + 8 * quad);
#pragma unroll
            for (int dt = 0; dt < 4; ++dt) acc[dt] = MFMA16(af[dt][ks], bfr, acc[dt]); }
        const int tok = 16 * pt + ql; const float bias = ptab[PT_SGUB + g * 128 + tok];
#pragma unroll
        for (int dt = 0; dt < 4; ++dt) { const int col = g * 64 + 16 * dt + 4 * quad;
            const u32x2 uw = *(const u32x2*)(zu + (size_t)tok * 512 + col);
            *(u32x2*)(aout + (size_t)tok * 512 + col) = (u32x2){cvt_pk_bf16(bflo(uw.x) * (acc[dt][0] + bias), bfhi(uw.x) * (acc[dt][1] + bias)), cvt_pk_bf16(bflo(uw.y) * (acc[dt][2] + bias), bfhi(uw.y) * (acc[dt][3] + bias))}; }
    }
    __syncthreads();
}

#ifndef PHM
#define PHM 127
#endif
#ifndef IM
#define IM 7
#endif
#define GRID_SYNC() do { asm volatile("s_waitcnt vmcnt(0)" ::: "memory"); __syncthreads(); \
    grid.sync(); \
    if (threadIdx.x < 64) { __builtin_amdgcn_fence(__ATOMIC_ACQUIRE, "agent"); asm volatile("s_waitcnt vmcnt(0)" ::: "memory"); } __syncthreads(); } while (0)
__global__ void __launch_bounds__(512, 2) fwd(Args a) {
    extern __shared__ __attribute__((aligned(16))) unsigned char lds_raw[];
    LAS unsigned char* lds = (LAS unsigned char*)lds_raw;
    cg::grid_group grid = cg::this_grid();
    int s = a.lo;
    if (s == 0) {
        unsigned char* ws = a.ws; int tid = threadIdx.x, bx = blockIdx.x, G = gridDim.x;
        const int lane = tid & 63, wave = __builtin_amdgcn_readfirstlane(tid >> 6), gw = bx * 8 + wave, ngw = G * 8;
        if (PHM & 1) prologue(a, ws, lds, gw, ngw, wave, lane);
        ++s; if (s < a.hi) GRID_SYNC();
    }
#ifdef PROBE_P
    int probe_rep = 0;
#ifdef PROBE_IM
#define PROBE_SEL(x) (!probe_rep || (PROBE_IM & (x)))
#else
#define PROBE_SEL(x) true
#endif
#else
#define PROBE_SEL(x) true
#endif
    for (; s < a.hi; ++s) {
        size_t zo = 0; int bx = blockIdx.x, G = gridDim.x;
        asm volatile("" : "+s"(zo), "+s"(bx), "+s"(G));
        unsigned char* ws = a.ws + zo;
        const int t = s - 1, c = t / 24, l = (t % 24) / 6, p = t % 6;
        const int lgS = c < 2 ? 11 : 12;
        unsigned char* wl = ws + WS_W + (size_t)l * WL;
        const size_t xbo = (c & 1) ? WS_XB2 : WS_XB, xbn = (c & 1) ? WS_XB : WS_XB2;
        if (p == 0 && (PHM & 2)) {
            pg8::Gemm g{(const bf16_t*)(ws + xbo), (const bf16_t*)(wl + W_IN), MC, ZN, 1024}; pg8::StaticOrder S; S.init(MC, ZN, G, bx);
            EpiWin E{ws, l, lgS, (LAS float*)(lds + 131072)};
            pg8::gemm_phase<EpiWin, pg8::StaticOrder, true, true>(lds, g, S, E);
        } else if (p == 1 && (PHM & 4)) {
            int tid = threadIdx.x; asm volatile("" : "+v"(tid));
            const int lane = tid & 63, wave = __builtin_amdgcn_readfirstlane(tid >> 6);
            const int nqb = (1 << lgS) / 128, NC = (MC / 128) * 4, NB = (MC / 256) * 2, NA = MC / 128;
            {
            const int vbx = (G & 7) == 0 ? (bx & 7) * (G >> 3) + (bx >> 3) : bx;
            if ((IM & 1) && PROBE_SEL(1)) for (int it = vbx; it < NC; it += G) { const int qb = it % nqb, bh = it / nqb; diffattn_item(ws, lds, l, lgS, bh >> 2, bh & 3, qb, tid, wave, lane); }
            if ((IM & 2) && PROBE_SEL(2)) for (int it = bx; it < NB; it += G) { const int j = it & 1, gsp = it >> 1, nsp = (1 << lgS) / 256; dilattn_item(ws, lds, lgS, gsp / nsp, gsp % nsp, j, tid, wave, lane); }
            if ((IM & 4) && PROBE_SEL(4)) for (int it = bx; it < NA; it += G) sgu_item(ws, lds, l, it, tid, wave, lane);
            }
        } else if (p == 2 && (PHM & 8)) {
            pg8::StaticOrder S; S.init(MC, 1024, G, bx);
#pragma nounroll
            for (int br = 0; br < 3; ++br) {
                const size_t aoff = br == 0 ? WS_AOUT : br == 1 ? WS_BOUT : WS_COUT, woff = br == 0 ? W_PA : br == 1 ? W_PB : W_PC;
                pg8::Gemm g{(const bf16_t*)(ws + aoff), (const bf16_t*)(wl + woff), MC, 1024, br == 1 ? 384 : 512}; EpiWp E{ws, br};
                pg8::gemm_phase<EpiWp, pg8::StaticOrder, true, true>(lds, g, S, E);
            }
        } else if ((p == 3 && (PHM & 16)) || (p == 5 && (PHM & 64))) {
            float* xout = a.out + (size_t)c * MC * 1024 + zo;
            const bool wo = p == 3;
            pg8::Gemm g{(const bf16_t*)(ws + (wo ? WS_MERGED : WS_HID)), (const bf16_t*)(wl + (wo ? W_O : W_DN)), MC, 1024, wo ? 1024 : DFF}; pg8::StaticOrder S; S.init(MC, 1024, G, bx);
            EpiRes E{xout, (bf16_t*)(ws + xbo), (float*)(ws + (wo ? WS_SS2 : WS_SS1)), (wo || l < DEPTH - 1) ? 1 : 0};
            pg8::gemm_phase<EpiRes, pg8::StaticOrder, true, true>(lds, g, S, E);
            if (!wo && l == DEPTH - 1 && c + 1 < NCHUNK) {
                int tid = threadIdx.x; asm volatile("" : "+v"(tid));
                const int lane = tid & 63, wave = __builtin_amdgcn_readfirstlane(tid >> 6);
                const float* xn = ((c + 1) < 2 ? a.in[I_XP] + (size_t)(c + 1) * MC * 1024 : a.in[I_XS]) + zo;
                prep_chunk(xn, (bf16_t*)(ws + xbn), (float*)(ws + WS_SS1), bx * 8 + wave, G * 8, lane);
            }
        } else if (p == 4 && (PHM & 32)) {
            pg8::Gemm g{(const bf16_t*)(ws + xbo), (const bf16_t*)(wl + W_GU), MC, 2 * DFF, 1024}; pg8::StaticOrder S; S.init(MC, 2 * DFF, G, bx);
            EpiGu E{(const float*)(ws + WS_SS2), (bf16_t*)(ws + WS_HID), (LAS float*)(lds + 131072)};
            pg8::gemm_phase<EpiGu, pg8::StaticOrder, true, true>(lds, g, S, E);
        }
        if (s + 1 < a.hi) GRID_SYNC();
#ifdef PROBE_P
        if (p == PROBE_P && !probe_rep) { probe_rep = 1; --s; } else probe_rep = 0;
#endif
    }
}

#ifndef MK_MULTI
#define MK_MULTI 0
#endif
extern "C" void kernel_launch(void* const* d_in, const int* in_sizes, int n_in, void* d_out, int out_size, void* d_ws, size_t ws_size, hipStream_t stream) {
    static int grid = 0;
    if (grid == 0) {
        if (n_in != 25 || ws_size < WS_END) { fprintf(stderr, "kernel_launch: need 25 inputs and %zu bytes of workspace (got %d, %zu)\n", (size_t)WS_END, n_in, ws_size); grid = -1; return; }
        int dev = 0, cus = 0, per_cu = 0;
        if (hipGetDevice(&dev) != hipSuccess || hipDeviceGetAttribute(&cus, hipDeviceAttributeMultiprocessorCount, dev) != hipSuccess) { grid = -1; return; }
        if (hipFuncSetAttribute((const void*)fwd, hipFuncAttributeMaxDynamicSharedMemorySize, LDS_BYTES) != hipSuccess) { fprintf(stderr, "kernel_launch: hipFuncSetAttribute failed\n"); grid = -1; return; }
        if (hipOccupancyMaxActiveBlocksPerMultiprocessor(&per_cu, (const void*)fwd, 512, LDS_BYTES) != hipSuccess || per_cu < 1) per_cu = 1;
        (void)hipGetLastError();
        grid = cus * per_cu;
        fprintf(stderr, "kernel_launch: grid %d (%d CUs x %d), ws %zu\n", grid, cus, per_cu, ws_size);
    }
    if (grid < 0) return;
    Args a{};
    for (int i = 0; i < 25; ++i) a.in[i] = (const float*)d_in[i];
    a.out = (float*)d_out; a.ws = (unsigned char*)d_ws;
#if MK_MULTI
    for (int s = 0; s < NSTEPS; ++s) { a.lo = s; a.hi = s + 1; void* args[] = {&a};
        hipError_t e = hipLaunchCooperativeKernel((const void*)fwd, dim3(grid), dim3(512), args, LDS_BYTES, stream);
        if (e != hipSuccess) { fprintf(stderr, "kernel_launch: launch %d failed: %s\n", s, hipGetErrorString(e)); break; } }
#else
    a.lo = 0; a.hi = NSTEPS; void* args[] = {&a};
    hipError_t e = hipLaunchCooperativeKernel((const void*)fwd, dim3(grid), dim3(512), args, LDS_BYTES, stream);
    if (e != hipSuccess) fprintf(stderr, "kernel_launch: cooperative launch failed: %s (grid %d)\n", hipGetErrorString(e), grid);
#endif
}
```

```cpp
#include <hip/hip_runtime.h>
#include <hip/hip_cooperative_groups.h>
#include <cstdio>
#include <cstdint>
namespace cg = cooperative_groups;
namespace pg8 {
#define PG8_LAS __attribute__((address_space(3)))
typedef unsigned short bf16_t;
typedef short bf16x8 __attribute__((ext_vector_type(8)));
typedef float f32x4 __attribute__((ext_vector_type(4)));
typedef unsigned u32x4 __attribute__((ext_vector_type(4)));
constexpr int BM = 256, BK = 64, HALF = 128, HTB = HALF * BK * 2  , STAGE_BYTES = 8 * HTB, NXCD = 8, WGM = 8;

__host__ __device__ __forceinline__ int lds_byte(int r, int c) { const int st = (r >> 4) * 2 + (c >> 5), rr = r & 15, cc = c & 31, ob = rr * 64 + cc * 2; return st * 1024 + (ob ^ (((ob >> 9) & 1) << 5)); }
__host__ __device__ __forceinline__ void stage_rc(int b, int& R, int& C) { const int st = b / 1024, sb = b % 1024, swz = sb ^ (((sb >> 9) & 1) << 5); R = (st >> 1) * 16 + swz / 64; C = (st & 1) * 32 + (swz % 64) / 2; }
__host__ __device__ __forceinline__ int perm32(int rho) { const int n = rho >> 4, i = rho & 15; return 8 * (i >> 2) + 4 * n + (i & 3); }

struct Unit { int pm, pn; };
struct Gemm { const bf16_t* A; const bf16_t* Bt; int M, N, K; };

struct StaticOrder {
    int nM, nN, nwg, G, c;
    __host__ __device__ void init(int M, int N, int G_, int c_) { nM = M / BM; nN = N / BM; nwg = nM * nN; G = G_; c = c_; }
    __host__ __device__ bool next(int i, Unit& u) const {
        const long L = (long)i * G + c; if (L >= nwg) return false;
        int wgid = (int)L; { const int q = nwg / NXCD, r = nwg % NXCD, xcd = wgid % NXCD, off = wgid / NXCD; wgid = (xcd < r ? xcd * (q + 1) : r * (q + 1) + (xcd - r) * q) + off; }
        const int nig = WGM * nN, gid = wgid / nig, fm = gid * WGM, gsz = (nM - fm) < WGM ? (nM - fm) : WGM;
        u.pm = fm + ((wgid % nig) % gsz); u.pn = (wgid % nig) / gsz; return true;
    }
    __device__ __forceinline__ void a_ready(const Unit&) const {}
    __device__ __forceinline__ void done(const Unit&) const {}
};

__device__ __forceinline__ unsigned cvt_pk_bf16(float lo, float hi) { unsigned r; asm volatile("v_cvt_pk_bf16_f32 %0, %1, %2" : "=v"(r) : "v"(lo), "v"(hi)); return r; }
template <class Epi, class Sched, bool ALIGN_EPI = false, bool SP2 = false>
__device__ __forceinline__ void gemm_phase(PG8_LAS unsigned char* lds, const Gemm g, const Sched& S, const Epi& E) {
    int tid_ = threadIdx.x; asm volatile("" : "+v"(tid_));
    const int tid = tid_, wid = __builtin_amdgcn_readfirstlane(tid >> 6), lane = tid & 63, wr = wid >> 2, wc = wid & 3, fr = lane & 15, fq = lane >> 4;
    const int K = g.K, nt = K / BK;
    unsigned voffA[2], voffB[2];
#pragma unroll
    for (int i = 0; i < 2; ++i) { int R, C; stage_rc(tid * 16 + i * 8192, R, C); const int Rb = Epi::PERM ? ((R & ~31) + perm32(R & 31)) : R;
        voffA[i] = (unsigned)(R * K + C) * 2u; voffB[i] = (unsigned)(Rb * K + C) * 2u; }
    const size_t kstep = (size_t)(BK * 2);
    const size_t hstep = (size_t)HALF * K * 2;
    const size_t tstep = 2 * hstep;
    const unsigned ldsw = (unsigned)wid * 1024u;
    const int aoff = lds_byte(wr * 64 + fr, fq * 8), boff = lds_byte(wc * 32 + fr, fq * 8);
#define PG8_SA(b, h) (((b) * 2 + (h)) * HTB)
#define PG8_SB(b, h) ((4 + (b) * 2 + (h)) * HTB)
#define PG8_STAGE(bufoff, gbase, voff) do { _Pragma("unroll") for (int _i = 0; _i < 2; ++_i) \
        __builtin_amdgcn_global_load_lds((const unsigned*)((const char*)(gbase) + (voff)[_i]), (PG8_LAS unsigned*)(lds + (bufoff) + ldsw + _i * 8192), 16, 0, 0); } while (0)
#define PG8_LDA(dst, b, h) do { _Pragma("unroll") for (int m = 0; m < 4; ++m) _Pragma("unroll") for (int k = 0; k < 2; ++k) dst[m][k] = *(const PG8_LAS bf16x8*)(lds + PG8_SA(b, h) + aoff + m * 2048 + k * 1024); } while (0)
#define PG8_LDB(dst, b, h) do { _Pragma("unroll") for (int n = 0; n < 2; ++n) _Pragma("unroll") for (int k = 0; k < 2; ++k) dst[n][k] = *(const PG8_LAS bf16x8*)(lds + PG8_SB(b, h) + boff + n * 2048 + k * 1024); } while (0)
#define PG8_MMA(ai, bj, At, Bt) do { __builtin_amdgcn_s_setprio(1); _Pragma("unroll") for (int m = 0; m < 4; ++m) _Pragma("unroll") for (int n = 0; n < 2; ++n) _Pragma("unroll") for (int k = 0; k < 2; ++k) \
        acc[ai][bj][m][n] = __builtin_amdgcn_mfma_f32_16x16x32_bf16(Bt[n][k], At[m][k], acc[ai][bj][m][n], 0, 0, 0); __builtin_amdgcn_s_setprio(0); } while (0)
#define PG8_WAIT_V(n) asm volatile("s_waitcnt vmcnt(" #n ")" ::: "memory")
#define PG8_WAIT_L(n) asm volatile("s_waitcnt lgkmcnt(" #n ")" ::: "memory")
#define PG8_BAR __builtin_amdgcn_s_barrier()
#define PG8_SCHED __builtin_amdgcn_sched_barrier(0)
    Unit cur, nxt; int ui = 0;
    if (!S.next(0, cur)) return;
    f32x4 acc[2][2][4][2];
#pragma unroll
    for (int a = 0; a < 2; ++a)
#pragma unroll
        for (int b = 0; b < 2; ++b)
#pragma unroll
            for (int m = 0; m < 4; ++m)
#pragma unroll
                for (int n = 0; n < 2; ++n) acc[a][b][m][n] = (f32x4){0.f, 0.f, 0.f, 0.f};
    bf16x8 At[4][2], B0[2][2], B1[2][2];
    const char* cA = (const char*)g.A + (size_t)cur.pm * tstep; const char* cB = (const char*)g.Bt + (size_t)cur.pn * tstep;
    S.a_ready(cur);
    if constexpr (SP2) {
        PG8_STAGE(PG8_SB(0, 0), cB, voffB); PG8_STAGE(PG8_SB(0, 1), cB + hstep, voffB); PG8_STAGE(PG8_SA(0, 0), cA, voffA); PG8_STAGE(PG8_SA(0, 1), cA + hstep, voffA);
        if (wr == 1) PG8_BAR;
        PG8_WAIT_V(2); PG8_BAR;
        PG8_STAGE(PG8_SB(1, 0), cB + kstep, voffB); PG8_STAGE(PG8_SA(1, 0), cA + kstep, voffA); PG8_STAGE(PG8_SB(1, 1), cB + hstep + kstep, voffB);
        PG8_WAIT_V(6); PG8_BAR;
    } else {
        PG8_STAGE(PG8_SB(0, 0), cB, voffB); PG8_STAGE(PG8_SA(0, 0), cA, voffA); PG8_STAGE(PG8_SB(0, 1), cB + hstep, voffB); PG8_STAGE(PG8_SA(0, 1), cA + hstep, voffA);
        if (wr == 1) PG8_BAR;
        PG8_WAIT_V(4); PG8_BAR;
        PG8_STAGE(PG8_SB(1, 0), cB + kstep, voffB); PG8_STAGE(PG8_SA(1, 0), cA + kstep, voffA); PG8_STAGE(PG8_SB(1, 1), cB + hstep + kstep, voffB);
        PG8_WAIT_V(6); PG8_BAR;
    }
    for (;;) {
        const bool has_next = S.next(ui + 1, nxt);
        const char* nA = has_next ? (const char*)g.A + (size_t)nxt.pm * tstep : cA; const char* nB = has_next ? (const char*)g.Bt + (size_t)nxt.pn * tstep : cB;
        for (int t = 0; t < nt; t += 2) {
            const bool last = (t == nt - 2);
            const char* a1 = cA + (size_t)(t + 1) * kstep;
            const char* a2 = last ? nA : cA + (size_t)(t + 2) * kstep; const char* b2 = last ? nB : cB + (size_t)(t + 2) * kstep;
            const char* a3 = a2 + kstep; const char* b3 = b2 + kstep;
            if (last && has_next) S.a_ready(nxt);
            if constexpr (SP2) {
            PG8_LDB(B0, 0, 0); PG8_LDB(B1, 0, 1); PG8_SCHED; PG8_LDA(At, 0, 0); PG8_STAGE(PG8_SA(1, 1), a1 + hstep, voffA);
            PG8_WAIT_V(8); PG8_WAIT_L(0); PG8_BAR; PG8_MMA(0, 0, At, B0); PG8_MMA(0, 1, At, B1); PG8_BAR; PG8_SCHED;
            PG8_LDA(At, 0, 1); PG8_STAGE(PG8_SB(0, 0), b2, voffB); PG8_STAGE(PG8_SB(0, 1), b2 + hstep, voffB); PG8_STAGE(PG8_SA(0, 0), a2, voffA);
            PG8_WAIT_V(8); PG8_WAIT_L(0); PG8_BAR; PG8_MMA(1, 0, At, B0); PG8_MMA(1, 1, At, B1); PG8_BAR; PG8_SCHED;
            PG8_LDB(B0, 1, 0); PG8_LDB(B1, 1, 1); PG8_SCHED; PG8_LDA(At, 1, 0); PG8_STAGE(PG8_SA(0, 1), a2 + hstep, voffA);
            PG8_WAIT_V(8); PG8_WAIT_L(0); PG8_BAR; PG8_MMA(0, 0, At, B0); PG8_MMA(0, 1, At, B1); PG8_BAR; PG8_SCHED;
            PG8_LDA(At, 1, 1); PG8_STAGE(PG8_SB(1, 0), b3, voffB); PG8_STAGE(PG8_SB(1, 1), b3 + hstep, voffB); PG8_STAGE(PG8_SA(1, 0), a3, voffA);
            PG8_WAIT_V(8); PG8_WAIT_L(0); PG8_BAR; PG8_MMA(1, 0, At, B0); PG8_MMA(1, 1, At, B1); PG8_BAR; PG8_SCHED;
            } else {
            PG8_LDB(B0, 0, 0); PG8_SCHED; PG8_LDA(At, 0, 0); PG8_STAGE(PG8_SA(1, 1), a1 + hstep, voffA);
            PG8_WAIT_L(8); PG8_BAR; PG8_WAIT_L(0); PG8_MMA(0, 0, At, B0); PG8_BAR; PG8_SCHED;
            PG8_LDB(B1, 0, 1); PG8_STAGE(PG8_SB(0, 0), b2, voffB);
            PG8_BAR; PG8_WAIT_L(0); PG8_MMA(0, 1, At, B1); PG8_BAR;
            PG8_LDA(At, 0, 1); PG8_STAGE(PG8_SA(0, 0), a2, voffA);
            PG8_BAR; PG8_WAIT_L(0); PG8_MMA(1, 0, At, B0); PG8_BAR; PG8_SCHED;
            PG8_STAGE(PG8_SB(0, 1), b2 + hstep, voffB);
            PG8_WAIT_V(6); PG8_BAR; PG8_MMA(1, 1, At, B1); PG8_BAR;
            PG8_LDB(B0, 1, 0); PG8_SCHED; PG8_LDA(At, 1, 0); PG8_STAGE(PG8_SA(0, 1), a2 + hstep, voffA);
            PG8_WAIT_L(8); PG8_BAR; PG8_WAIT_L(0); PG8_MMA(0, 0, At, B0); PG8_BAR; PG8_SCHED;
            PG8_LDB(B1, 1, 1); PG8_STAGE(PG8_SB(1, 0), b3, voffB);
            PG8_BAR; PG8_WAIT_L(0); PG8_MMA(0, 1, At, B1); PG8_BAR;
            PG8_LDA(At, 1, 1); PG8_STAGE(PG8_SA(1, 0), a3, voffA);
            PG8_BAR; PG8_WAIT_L(0); PG8_MMA(1, 0, At, B0); PG8_BAR; PG8_SCHED;
            PG8_STAGE(PG8_SB(1, 1), b3 + hstep, voffB);
            PG8_WAIT_V(6); PG8_BAR; PG8_MMA(1, 1, At, B1); PG8_BAR;
            }
        }
        if constexpr (ALIGN_EPI) { if (wr == 0) PG8_BAR; }
        if constexpr (!Epi::AFTER_DRAIN) { E(acc, cur, wr, wc, fr, fq); S.done(cur); }
        if (!has_next) break;
#pragma unroll
        for (int a = 0; a < 2; ++a)
#pragma unroll
            for (int b = 0; b < 2; ++b)
#pragma unroll
                for (int m = 0; m < 4; ++m)
#pragma unroll
                    for (int n = 0; n < 2; ++n) acc[a][b][m][n] = (f32x4){0.f, 0.f, 0.f, 0.f};
        cur = nxt; cA = nA; cB = nB; ++ui;
        if constexpr (ALIGN_EPI) { if (wr == 1) PG8_BAR; }
    }
    PG8_WAIT_V(0);
    if constexpr (!ALIGN_EPI) { if (wr == 0) PG8_BAR; }
    PG8_BAR;
    if constexpr (Epi::AFTER_DRAIN) { E.fused(acc, cur, wr, wc, fr, fq, lds, wid, lane); S.done(cur); }
#undef PG8_SA
#undef PG8_SB
#undef PG8_STAGE
#undef PG8_LDA
#undef PG8_LDB
#undef PG8_MMA
#undef PG8_WAIT_V
#undef PG8_WAIT_L
#undef PG8_BAR
#undef PG8_SCHED
}
}

using pg8::bf16_t; using pg8::bf16x8; using pg8::f32x4; using pg8::u32x4; using pg8::Unit;
typedef __bf16 bf16x2_t __attribute__((ext_vector_type(2)));
typedef float f32x2_t __attribute__((ext_vector_type(2)));
__device__ __forceinline__ unsigned cvt_pk_bf16(float lo, float hi) { const f32x2_t v = {lo, hi}; const bf16x2_t b = __builtin_convertvector(v, bf16x2_t); return __builtin_bit_cast(unsigned, b); }
typedef short s16x4 __attribute__((ext_vector_type(4)));
typedef unsigned u32x2 __attribute__((ext_vector_type(2)));
#define LAS __attribute__((address_space(3)))
constexpr int DM = 1024, DEPTH = 4, DFF = 2816, ZN = 6912, INC = 6784;
constexpr int MC = 32768;
constexpr int NCHUNK = 3;
constexpr int NQKH = 28, QKP = NQKH * 64;
constexpr float LOG2E = 1.4426950408889634f;
constexpr int LUTN = 8192, LUTOFF = 4096;
constexpr size_t MiB = 1u << 20;
constexpr size_t WS_LUT = 0, WS_GT = 512 * 1024, WS_PT = 768 * 1024, WS_W = 1 * MiB, WL = 35 * MiB;
constexpr size_t W_IN = 0, W_PA = 14155776, W_PB = 15204352, W_PC = 15990784, W_O = 17039360, W_GU = 19136512, W_DN = 30670848, W_SGU = 36438016;
static_assert(W_SGU + 8 * 128 * 128 * 2 == WL, "weight map");
constexpr size_t WS_XB = 141 * MiB, WS_ZU = 205 * MiB, WS_ZV = 237 * MiB, WS_QK = 269 * MiB, WS_VTB = 381 * MiB, WS_VTC = 405 * MiB, WS_GATE = 437 * MiB;
constexpr size_t WS_AOUT = 629 * MiB, WS_BOUT = 661 * MiB, WS_COUT = 685 * MiB, WS_MERGED = 717 * MiB, WS_SS1 = 781 * MiB, WS_SS2 = 783 * MiB, WS_LB = 785 * MiB, WS_XB2 = 786 * MiB, WS_END = 850 * MiB;
constexpr size_t WS_MF32 = WS_QK, WS_HID = WS_GATE;
static_assert(WS_W + 4 * WL == WS_XB && WS_QK + (size_t)MC * QKP * 2 == WS_VTB && WS_VTB + (size_t)MC * 384 * 2 == WS_VTC && WS_VTC + (size_t)MC * 512 * 2 == WS_GATE, "ws map");
static_assert(WS_MF32 + (size_t)MC * 1024 * 4 <= WS_GATE && WS_HID + (size_t)MC * DFF * 2 <= WS_AOUT && WS_GATE + (size_t)MC * 3072 * 2 == WS_AOUT, "ws alias map");
constexpr int PT_L = 4096, PT_SUBG = 0, PT_LNG = 128, PT_LNB = 640, PT_SGUB = 1152, PT_LAM = 2176;
constexpr int LDS_BYTES = 147456;
constexpr int NSTEPS = 1 + NCHUNK * DEPTH * 6;

struct Args { const float* in[25]; float* out; unsigned char* ws; int lo, hi; };
enum { I_XP = 0, I_XS, I_RELB, I_N1G, I_WIN, I_LNG, I_LNB, I_SGUW, I_SGUB, I_QNB, I_KNB, I_QNC, I_KNC, I_LQ1, I_LK1, I_LQ2, I_LK2, I_SUBG, I_WPA, I_WPB, I_WPC, I_WO, I_N2G, I_WGU, I_WDN };

__device__ __forceinline__ float bflo(unsigned w) { return __uint_as_float(w << 16); }
__device__ __forceinline__ float bfhi(unsigned w) { return __uint_as_float(w & 0xffff0000u); }
__device__ __forceinline__ float fexp2(float x) { return __builtin_amdgcn_exp2f(x); }
__device__ __forceinline__ float frcp(float x) { return __builtin_amdgcn_rcpf(x); }
__device__ __forceinline__ float sigmoidf_(float x) { return frcp(1.f + fexp2(-LOG2E * x)); }
__device__ __forceinline__ float gelu_tanh(float x) { const float u = 0.7978845608028654f * (x + 0.044715f * x * x * x); return x * frcp(1.f + fexp2(-2.f * LOG2E * u)); }
__device__ __forceinline__ float shx(float v, int lane, int o) { return __builtin_bit_cast(float, __builtin_amdgcn_ds_bpermute((lane ^ o) << 2, __builtin_bit_cast(int, v))); }
__device__ __forceinline__ float wave_sum(float v, int lane) {
#pragma unroll
    for (int o = 1; o < 64; o <<= 1) v += shx(v, lane, o);
    return v;
}
__device__ __forceinline__ float quad_sum(float v, int lane) { v += shx(v, lane, 16); v += shx(v, lane, 32); return v; }
__device__ __forceinline__ unsigned cvt_pk_asm(float lo, float hi) { unsigned r; asm volatile("s_nop 1\n\tv_cvt_pk_bf16_f32 %0, %1, %2" : "=v"(r) : "v"(lo), "v"(hi)); return r; }
__device__ __forceinline__ u32x4 pack8(const float* v) { u32x4 w; w.x = cvt_pk_asm(v[0], v[1]); w.y = cvt_pk_asm(v[2], v[3]); w.z = cvt_pk_asm(v[4], v[5]); w.w = cvt_pk_asm(v[6], v[7]); return w; }
__device__ __forceinline__ float ss_total(const float* ssp, size_t row) {
    float t = 0.f;
#pragma unroll
    for (int pn = 0; pn < 4; ++pn) { const f32x4 v = *(const f32x4*)(ssp + ((size_t)pn * MC + row) * 4); t += (v[0] + v[1]) + (v[2] + v[3]); }
    return t;
}
__device__ __forceinline__ void unit_row_scales(float (&rs)[2][4], const float* ssp, LAS float* rsb, int pm, int wr, int wc, int fr, int fq) {
    const int t = (wr * 4 + wc) * 64 + fq * 16 + fr;
    if (t < 256) rsb[t] = rsqrtf(ss_total(ssp, (size_t)pm * 256 + t) * (1.f / 1024.f) + 1e-6f);
    asm volatile("s_waitcnt lgkmcnt(0)" ::: "memory"); __builtin_amdgcn_s_barrier(); asm volatile("" ::: "memory");
#pragma unroll
    for (int ai = 0; ai < 2; ++ai)
#pragma unroll
        for (int m = 0; m < 4; ++m) rs[ai][m] = rsb[ai * 128 + wr * 64 + m * 16 + fr];
}
#define MFMA16(a, b, c) __builtin_amdgcn_mfma_f32_16x16x32_bf16((a), (b), (c), 0, 0, 0)

struct EpiWin {
    static constexpr bool PERM = true, AFTER_DRAIN = false;
    unsigned char* ws; int l, lgS; LAS float* rsb;
    __device__ __forceinline__ void operator()(const f32x4 (&acc)[2][2][4][2], const Unit& u, int wr, int wc, int fr, int fq) const {
        const int row0 = u.pm * 256 + wr * 64 + fr, pn = u.pn;
        const float* ss1 = (const float*)(ws + WS_SS1);
        float rs[2][4];
        unit_row_scales(rs, ss1, rsb, u.pm, wr, wc, fr, fq);
        if (pn < 4) {
            bf16_t* base = (bf16_t*)(ws + (pn < 2 ? WS_ZU : WS_ZV)) + (pn & 1) * 256 + wc * 32 + 8 * fq;
#pragma unroll
            for (int ai = 0; ai < 2; ++ai)
#pragma unroll
                for (int m = 0; m < 4; ++m) { const size_t row = row0 + ai * 128 + m * 16;
#pragma unroll
                    for (int bj = 0; bj < 2; ++bj) { float v[8];
#pragma unroll
                        for (int e = 0; e < 8; ++e) v[e] = gelu_tanh(acc[ai][bj][m][e >> 2][e & 3] * rs[ai][m]);
                        *(u32x4*)(base + row * 512 + bj * 128) = pack8(v); } __builtin_amdgcn_sched_barrier(0); }
        } else if (pn < 11) {
            const int hh = 4 * (pn - 4) + wc;
            const float* gp = (const float*)(ws + WS_GT) + (l * NQKH + hh) * 64;
            float g[2][8];
#pragma unroll
            for (int bj = 0; bj < 2; ++bj)
#pragma unroll
                for (int e = 0; e < 8; ++e) g[bj][e] = gp[32 * bj + 8 * fq + e];
            bf16_t* base = (bf16_t*)(ws + WS_QK) + hh * 64 + 8 * fq;
#pragma unroll
            for (int ai = 0; ai < 2; ++ai)
#pragma unroll
                for (int m = 0; m < 4; ++m) { const int rown = row0 + ai * 128 + m * 16; float ssq = 0.f;
                    size_t row = rown;
                    if (hh < 12) { const int lgd = 2 * ((hh < 6 ? hh : hh - 6) >> 1), s = rown & ((1 << lgS) - 1), nn = s >> lgd; row = (size_t)(rown - s) + ((((nn >> 4) << lgd) + (s & ((1 << lgd) - 1))) << 4) + (nn & 15); }
#pragma unroll
                    for (int bj = 0; bj < 2; ++bj)
#pragma unroll
                        for (int e = 0; e < 8; ++e) { const float t = acc[ai][bj][m][e >> 2][e & 3] * rs[ai][m]; ssq += t * t; }
                    ssq = quad_sum(ssq, fq * 16 + fr);
                    const float r = rsqrtf(ssq * (1.f / 64.f) + 1e-6f) * rs[ai][m];
#pragma unroll
                    for (int bj = 0; bj < 2; ++bj) { float v[8];
#pragma unroll
                        for (int e = 0; e < 8; ++e) v[e] = acc[ai][bj][m][e >> 2][e & 3] * r * g[bj][e];
                        *(u32x4*)(base + row * QKP + 32 * bj) = pack8(v); } __builtin_amdgcn_sched_barrier(0); }
        } else if (pn < 15) {
            const int S = 1 << lgS;
#pragma unroll
            for (int bj = 0; bj < 2; ++bj) {
                const int vch0 = (pn - 11) * 256 + 128 * bj + 32 * wc + 8 * fq;
                if (vch0 >= 896) continue;
                const bool isB = vch0 < 384; const int lg = isB ? 2 * (vch0 >> 7) : 0;
#pragma unroll
                for (int ai = 0; ai < 2; ++ai)
#pragma unroll
                    for (int m = 0; m < 4; ++m) { const int row = row0 + ai * 128 + m * 16; const int b = row >> lgS, s = row & (S - 1);
                        const int nn = s >> lg, idx = ((((nn >> 4) << lg) + (s & ((1 << lg) - 1))) << 4) + (nn & 15);
                        bf16_t* dst = isB ? (bf16_t*)(ws + WS_VTB) + ((size_t)(b * 384 + vch0) << lgS) + idx : (bf16_t*)(ws + WS_VTC) + ((size_t)(b * 512 + vch0 - 384) << lgS) + s;
#pragma unroll
                        for (int e = 0; e < 8; e += 2) { const unsigned w = cvt_pk_asm(acc[ai][bj][m][e >> 2][e & 3] * rs[ai][m], acc[ai][bj][m][e >> 2][(e & 3) + 1] * rs[ai][m]);
                            dst[(size_t)e << lgS] = (bf16_t)(w & 0xffffu); dst[(size_t)(e + 1) << lgS] = (bf16_t)(w >> 16); } __builtin_amdgcn_sched_barrier(0); }
            }
        } else {
            bf16_t* base = (bf16_t*)(ws + WS_GATE) + (pn - 15) * 256 + wc * 32 + 8 * fq;
#pragma unroll
            for (int ai = 0; ai < 2; ++ai)
#pragma unroll
                for (int m = 0; m < 4; ++m) { const size_t row = row0 + ai * 128 + m * 16;
#pragma unroll
                    for (int bj = 0; bj < 2; ++bj) { float v[8];
#pragma unroll
                        for (int e = 0; e < 8; ++e) v[e] = sigmoidf_(acc[ai][bj][m][e >> 2][e & 3] * rs[ai][m]);
                        *(u32x4*)(base + row * 3072 + bj * 128) = pack8(v); } __builtin_amdgcn_sched_barrier(0); }
        }
    }
};
struct EpiWp {
    static constexpr bool PERM = true, AFTER_DRAIN = false;
    unsigned char* ws; int BR;
    __device__ __forceinline__ void operator()(const f32x4 (&acc)[2][2][4][2], const Unit& u, int wr, int wc, int fr, int fq) const {
        const int row0 = u.pm * 256 + wr * 64 + fr, col0 = u.pn * 256 + wc * 32 + 8 * fq;
        const bf16_t* gate = (const bf16_t*)(ws + WS_GATE); bf16_t* merged = (bf16_t*)(ws + WS_MERGED);
        u32x4 gwv[2][4][2];
#pragma unroll
        for (int ai = 0; ai < 2; ++ai)
#pragma unroll
            for (int m = 0; m < 4; ++m)
#pragma unroll
                for (int bj = 0; bj < 2; ++bj) gwv[ai][m][bj] = *(const u32x4*)(gate + (size_t)(row0 + ai * 128 + m * 16) * 3072 + BR * 1024 + col0 + bj * 128);
        __builtin_amdgcn_sched_barrier(0);
#pragma unroll
        for (int ai = 0; ai < 2; ++ai)
#pragma unroll
            for (int m = 0; m < 4; ++m) { const size_t row = row0 + ai * 128 + m * 16;
#pragma unroll
                for (int bj = 0; bj < 2; ++bj) { const int col = col0 + bj * 128;
                    const u32x4 gw = gwv[ai][m][bj];
                    float v[8];
                    v[0] = bflo(gw.x) * acc[ai][bj][m][0][0]; v[1] = bfhi(gw.x) * acc[ai][bj][m][0][1]; v[2] = bflo(gw.y) * acc[ai][bj][m][0][2]; v[3] = bfhi(gw.y) * acc[ai][bj][m][0][3];
                    v[4] = bflo(gw.z) * acc[ai][bj][m][1][0]; v[5] = bfhi(gw.z) * acc[ai][bj][m][1][1]; v[6] = bflo(gw.w) * acc[ai][bj][m][1][2]; v[7] = bfhi(gw.w) * acc[ai][bj][m][1][3];
                    bf16_t* mp = merged + row * 1024 + col;
                    if (BR > 0) { const u32x4 pm = *(const u32x4*)mp;
                        v[0] += bflo(pm.x); v[1] += bfhi(pm.x); v[2] += bflo(pm.y); v[3] += bfhi(pm.y); v[4] += bflo(pm.z); v[5] += bfhi(pm.z); v[6] += bflo(pm.w); v[7] += bfhi(pm.w); }
                    *(u32x4*)mp = pack8(v); } }
    }
};
struct EpiRes {
    static constexpr bool PERM = true, AFTER_DRAIN = false;
    float* xout; bf16_t* xb; float* ss; int next;
    __device__ __forceinline__ void operator()(const f32x4 (&acc)[2][2][4][2], const Unit& u, int wr, int wc, int fr, int fq) const {
        const int row0 = u.pm * 256 + wr * 64 + fr, col0 = u.pn * 256 + wc * 32 + 8 * fq;
        u32x4 xwv[2][4][2];
#pragma unroll
        for (int ai = 0; ai < 2; ++ai)
#pragma unroll
            for (int m = 0; m < 4; ++m)
#pragma unroll
                for (int bj = 0; bj < 2; ++bj) xwv[ai][m][bj] = *(const u32x4*)(xb + (size_t)(row0 + ai * 128 + m * 16) * 1024 + col0 + bj * 128);
        __builtin_amdgcn_sched_barrier(0);
#pragma unroll
        for (int ai = 0; ai < 2; ++ai)
#pragma unroll
            for (int m = 0; m < 4; ++m) { const size_t row = row0 + ai * 128 + m * 16; float part = 0.f;
#pragma unroll
                for (int bj = 0; bj < 2; ++bj) { const int col = col0 + bj * 128;
                    const u32x4 xw = xwv[ai][m][bj];
                    float v[8];
                    v[0] = bflo(xw.x) + acc[ai][bj][m][0][0]; v[1] = bfhi(xw.x) + acc[ai][bj][m][0][1]; v[2] = bflo(xw.y) + acc[ai][bj][m][0][2]; v[3] = bfhi(xw.y) + acc[ai][bj][m][0][3];
                    v[4] = bflo(xw.z) + acc[ai][bj][m][1][0]; v[5] = bfhi(xw.z) + acc[ai][bj][m][1][1]; v[6] = bflo(xw.w) + acc[ai][bj][m][1][2]; v[7] = bfhi(xw.w) + acc[ai][bj][m][1][3];
                    if (next) { *(u32x4*)(xb + row * 1024 + col) = pack8(v);
#pragma unroll
                        for (int e = 0; e < 8; ++e) part += v[e] * v[e]; }
                    else { *(f32x4*)(xout + row * 1024 + col) = (f32x4){v[0], v[1], v[2], v[3]}; *(f32x4*)(xout + row * 1024 + col + 4) = (f32x4){v[4], v[5], v[6], v[7]}; } }
                if (next) { part = quad_sum(part, fq * 16 + fr); if (fq == 0) ss[((size_t)u.pn * MC + row) * 4 + wc] = part; } }
    }
};
struct EpiGu {
    static constexpr bool PERM = true, AFTER_DRAIN = false;
    const float* ss2; bf16_t* hid; LAS float* rsb;
    __device__ __forceinline__ void operator()(const f32x4 (&acc)[2][2][4][2], const Unit& u, int wr, int wc, int fr, int fq) const {
        const int row0 = u.pm * 256 + wr * 64 + fr, col0 = u.pn * 128 + wc * 32 + 8 * fq;
        float rsv[2][4];
        unit_row_scales(rsv, ss2, rsb, u.pm, wr, wc, fr, fq);
#pragma unroll
        for (int ai = 0; ai < 2; ++ai)
#pragma unroll
            for (int m = 0; m < 4; ++m) { const size_t row = row0 + ai * 128 + m * 16;
                const float rs = rsv[ai][m]; float v[8];
#pragma unroll
                for (int e = 0; e < 8; ++e) { const float g = acc[ai][0][m][e >> 2][e & 3] * rs, uu = acc[ai][1][m][e >> 2][e & 3] * rs; v[e] = g * sigmoidf_(g) * uu; }
                *(u32x4*)(hid + row * DFF + col0) = pack8(v); }
    }
};

__device__ __forceinline__ int win_src(int n) {
    const int t = n >> 8, w = n & 255;
    if (t < 4) return n;
    if (t < 11) { const int hh = 4 * (t - 4) + ((w & 127) >> 5), d = (w >> 7) * 32;
        const int base = hh < 6 ? 1024 + hh * 64 : hh < 12 ? 1408 + (hh - 6) * 64 : hh < 20 ? 2176 + (hh - 12) * 64 : 2688 + (hh - 20) * 64; return base + d; }
    if (t < 15) { const int v = (t - 11) * 256 + w; return v < 384 ? 1792 + v : v < 896 ? 3200 + (v - 384) : -1; }
    return 3712 + (t - 15) * 256 + w;
}
__device__ __forceinline__ int wgu_src(int n) { const int t = n >> 8, w = n & 255; return w < 128 ? t * 128 + w : DFF + t * 128 + (w - 128); }
__device__ __forceinline__ void cvt_item(const float* W, int K, int N, bf16_t* WT, const float* rscale, int src0, int n0, int k0, LAS float* scr, int lane) {
    if (src0 < 0) {
        const int c = lane & 7;
#pragma unroll
        for (int j = 0; j < 4; ++j) { const int n = (lane >> 3) + 8 * j; *(u32x4*)(WT + (size_t)(n0 + n) * K + k0 + 8 * c) = (u32x4){0u, 0u, 0u, 0u}; }
        return;
    }
#pragma unroll 8
    for (int i = 0; i < 32; ++i) { const int kk = 2 * i + (lane >> 5); float v = W[(size_t)(k0 + kk) * N + src0 + (lane & 31)]; if (rscale) v *= rscale[k0 + kk]; scr[kk * 33 + (lane & 31)] = v; }
    asm volatile("s_waitcnt lgkmcnt(0)" ::: "memory");
    const int c = lane & 7;
#pragma unroll
    for (int j = 0; j < 4; ++j) { const int n = (lane >> 3) + 8 * j; const LAS float* s = scr + (8 * c) * 33 + n;
        u32x4 o; o.x = cvt_pk_bf16(s[0 * 33], s[1 * 33]); o.y = cvt_pk_bf16(s[2 * 33], s[3 * 33]); o.z = cvt_pk_bf16(s[4 * 33], s[5 * 33]); o.w = cvt_pk_bf16(s[6 * 33], s[7 * 33]);
        *(u32x4*)(WT + (size_t)(n0 + n) * K + k0 + 8 * c) = o; }
    asm volatile("s_waitcnt lgkmcnt(0)" ::: "memory");
}
__device__ __forceinline__ int rel_bucket(int rel) {
    const int n = rel < 0 ? -rel : rel; int b;
    if (n < 8) b = n; else b = 8 + (n >= 15) + (n >= 27) + (n >= 50) + (n >= 91) + (n >= 166) + (n >= 305) + (n >= 559);
    return b + (rel > 0 ? 16 : 0);
}
__device__ __forceinline__ void prep_chunk(const float* x, bf16_t* xb, float* ss1, int gw, int ngw, int lane) {
    for (int r0 = gw * 16; r0 < MC; r0 += ngw * 16) {
        float mine = 0.f;
        for (int k = 0; k < 16; ++k) { const int r = r0 + k;
            const f32x4* xr = (const f32x4*)(x + (size_t)r * 1024) + lane; float s = 0.f; f32x4 v[4];
#pragma unroll
            for (int j = 0; j < 4; ++j) { v[j] = xr[64 * j]; s += (v[j][0] * v[j][0] + v[j][1] * v[j][1]) + (v[j][2] * v[j][2] + v[j][3] * v[j][3]); }
            s = wave_sum(s, lane);
            u32x2* o = (u32x2*)(xb + (size_t)r * 1024) + lane;
#pragma unroll
            for (int j = 0; j < 4; ++j) o[64 * j] = (u32x2){cvt_pk_bf16(v[j][0], v[j][1]), cvt_pk_bf16(v[j][2], v[j][3])};
            if (lane == k) mine = s; }
        if (lane < 16) {
#pragma unroll
            for (int pn = 0; pn < 4; ++pn) *(f32x4*)(ss1 + ((size_t)pn * MC + r0 + lane) * 4) = (f32x4){pn == 0 ? mine : 0.f, 0.f, 0.f, 0.f}; }
    }
}
__device__ __forceinline__ void prologue(const Args& a, unsigned char* ws, LAS unsigned char* lds, int gw, int ngw, int wave, int lane) {
    LAS float* scr = (LAS float*)(lds + wave * 8448);
    constexpr int I0 = 3456, I1 = I0 + 256, I2 = I1 + 192, I3 = I2 + 256, I4 = I3 + 512, I5 = I4 + 2816, I6 = I5 + 1408;
    for (int it = gw; it < DEPTH * I6; it += ngw) {
        const int l = it / I6; int r = it % I6; unsigned char* wl = ws + WS_W + (size_t)l * WL;
        if (r < I0) { const int kb = r / 216, nb = r % 216; cvt_item(a.in[I_WIN] + (size_t)l * 1024 * INC, 1024, INC, (bf16_t*)(wl + W_IN), a.in[I_N1G] + l * 1024, win_src(nb * 32), nb * 32, kb * 64, scr, lane); continue; }
        if (r < I1) { r -= I0; const int kb = r / 32, nb = r % 32; cvt_item(a.in[I_WPA] + (size_t)l * 512 * 1024, 512, 1024, (bf16_t*)(wl + W_PA), nullptr, nb * 32, nb * 32, kb * 64, scr, lane); continue; }
        if (r < I2) { r -= I1; const int kb = r / 32, nb = r % 32; cvt_item(a.in[I_WPB] + (size_t)l * 384 * 1024, 384, 1024, (bf16_t*)(wl + W_PB), nullptr, nb * 32, nb * 32, kb * 64, scr, lane); continue; }
        if (r < I3) { r -= I2; const int kb = r / 32, nb = r % 32; cvt_item(a.in[I_WPC] + (size_t)l * 512 * 1024, 512, 1024, (bf16_t*)(wl + W_PC), nullptr, nb * 32, nb * 32, kb * 64, scr, lane); continue; }
        if (r < I4) { r -= I3; const int kb = r / 32, nb = r % 32; cvt_item(a.in[I_WO] + (size_t)l * 1024 * 1024, 1024, 1024, (bf16_t*)(wl + W_O), nullptr, nb * 32, nb * 32, kb * 64, scr, lane); continue; }
        if (r < I5) { r -= I4; const int kb = r / 176, nb = r % 176; cvt_item(a.in[I_WGU] + (size_t)l * 1024 * 2 * DFF, 1024, 2 * DFF, (bf16_t*)(wl + W_GU), a.in[I_N2G] + l * 1024, wgu_src(nb * 32), nb * 32, kb * 64, scr, lane); continue; }
        { r -= I5; const int kb = r / 32, nb = r % 32; cvt_item(a.in[I_WDN] + (size_t)l * DFF * 1024, DFF, 1024, (bf16_t*)(wl + W_DN), nullptr, nb * 32, nb * 32, kb * 64, scr, lane); }
    }
    for (int i = gw * 64 + lane; i < DEPTH * 8 * 128 * 128 / 8; i += ngw * 64) {
        const int l = i / (8 * 128 * 128 / 8), r = i % (8 * 128 * 128 / 8);
        const f32x4 p = *(const f32x4*)(a.in[I_SGUW] + (size_t)i * 8), q = *(const f32x4*)(a.in[I_SGUW] + (size_t)i * 8 + 4);
        *(u32x4*)((bf16_t*)(ws + WS_W + (size_t)l * WL + W_SGU) + (size_t)r * 8) = (u32x4){cvt_pk_bf16(p[0], p[1]), cvt_pk_bf16(p[2], p[3]), cvt_pk_bf16(q[0], q[1]), cvt_pk_bf16(q[2], q[3])};
    }
    float* lut = (float*)(ws + WS_LUT);
    for (int i = gw * 64 + lane; i < 10 * LUTN; i += ngw * 64) { const int h = i / LUTN, rel = (i % LUTN) - LUTOFF; lut[i] = a.in[I_RELB][rel_bucket(rel) * 10 + h] * LOG2E; }
    float* pt = (float*)(ws + WS_PT);
    for (int i = gw * 64 + lane; i < DEPTH * 2176; i += ngw * 64) { const int l = i / 2176, r = i % 2176;
        pt[l * PT_L + r] = r < 128 ? a.in[I_SUBG][l * 128 + r] : r < 640 ? a.in[I_LNG][l * 512 + r - 128] : r < 1152 ? a.in[I_LNB][l * 512 + r - 640] : a.in[I_SGUB][l * 1024 + r - 1152]; }
    if (gw < DEPTH) { const int l = gw;
        const float s1 = wave_sum(a.in[I_LQ1][l * 64 + lane] * a.in[I_LK1][l * 64 + lane], lane), s2 = wave_sum(a.in[I_LQ2][l * 64 + lane] * a.in[I_LK2][l * 64 + lane], lane);
        const float lam_init = 0.8f - 0.6f * expf(-0.3f * (float)l);
        if (lane == 0) { pt[l * PT_L + PT_LAM] = expf(s1) - expf(s2) + lam_init; pt[l * PT_L + PT_LAM + 1] = lam_init; } }
    float* gt = (float*)(ws + WS_GT);
    for (int i = gw * 64 + lane; i < DEPTH * NQKH * 64; i += ngw * 64) { const int l = i / (NQKH * 64), hh = (i / 64) % NQKH, d = i % 64;
        const float* gp = hh < 6 ? a.in[I_QNB] : hh < 12 ? a.in[I_KNB] : hh < 20 ? a.in[I_QNC] : a.in[I_KNC];
        gt[i] = gp[l * 64 + d] * ((hh < 6 || (hh >= 12 && hh < 20)) ? 0.125f * LOG2E : 1.f); }
    prep_chunk(a.in[I_XP], (bf16_t*)(ws + WS_XB), (float*)(ws + WS_SS1), gw, ngw, lane);
}

constexpr int DA_KB = 16384, DA_STG = 32768;
__device__ __forceinline__ void diffattn_item(unsigned char* ws, LAS unsigned char* lds, int l, int lgS, int b, int h, int qb, int tid, int wave, int lane) {
    const int S = 1 << lgS, T = S >> 6;
    LAS float* lut = (LAS float*)lds;
    LAS unsigned char* stg = lds + 32768;
    const int ql = lane & 15, quad = lane >> 4, q0 = qb * 128 + wave * 16;
    const bf16_t* qkb = (const bf16_t*)(ws + WS_QK) + ((size_t)b << lgS) * QKP;
    const bf16_t* kg[2]; const bf16_t* vg[2];
#pragma unroll
    for (int i = 0; i < 2; ++i) { const int P = (i * 8 + wave) * 64 + lane, key = P >> 4, seg = (P & 15) ^ (key & 15), e = P >> 3, part = (P & 7) ^ ((e >> 1) & 7);
        kg[i] = qkb + (size_t)key * QKP + (20 + (seg >> 3) * 4 + h) * 64 + (seg & 7) * 8;
        vg[i] = (const bf16_t*)(ws + WS_VTC) + ((size_t)(b * 512 + h * 128 + e) << lgS) + part * 8; }
#define DA_DMA(tt, sidx) do { _Pragma("unroll") for (int i = 0; i < 2; ++i) { \
        __builtin_amdgcn_global_load_lds((const unsigned*)(kg[i] + (size_t)(tt) * 64 * QKP), (LAS unsigned*)(stg + (sidx) * DA_STG + (i * 8 + wave) * 1024), 16, 0, 0); \
        __builtin_amdgcn_global_load_lds((const unsigned*)(vg[i] + (tt) * 64), (LAS unsigned*)(stg + (sidx) * DA_STG + DA_KB + (i * 8 + wave) * 1024), 16, 0, 0); } } while (0)
    DA_DMA(0, 0); DA_DMA(1, 1);
    { const float* glut = (const float*)(ws + WS_LUT) + (6 + h) * LUTN;
      for (int i = tid; i < LUTN; i += 512) lut[i] = glut[i]; }
    bf16x8 qf[2][2];
#pragma unroll
    for (int c = 0; c < 2; ++c)
#pragma unroll
        for (int ks = 0; ks < 2; ++ks) qf[c][ks] = *(const bf16x8*)(qkb + (size_t)(q0 + ql) * QKP + (12 + c * 4 + h) * 64 + 32 * ks + 8 * quad);
    f32x4 o[2][8];
#pragma unroll
    for (int c = 0; c < 2; ++c)
#pragma unroll
        for (int dt = 0; dt < 8; ++dt) o[c][dt] = (f32x4){0.f, 0.f, 0.f, 0.f};
    float lsum0 = 0.f, lsum1 = 0.f;
    const LAS float* lutq = lut + LUTOFF - (q0 + ql) + 4 * quad;
    int kfo[2][2], vfo[2][2];
#pragma unroll
    for (int c = 0; c < 2; ++c)
#pragma unroll
        for (int ks = 0; ks < 2; ++ks) kfo[c][ks] = ql * 256 + (((c * 8 + ks * 4 + quad) ^ ql) << 4);
#pragma unroll
    for (int hf = 0; hf < 2; ++hf)
#pragma unroll
        for (int x = 0; x < 2; ++x) vfo[hf][x] = DA_KB + ql * 128 + (((4 * hf + (quad >> 1) + 2 * x) ^ ((ql >> 1) & 7)) << 4) + 8 * (quad & 1);
    asm volatile("s_waitcnt vmcnt(4) lgkmcnt(0)" ::: "memory"); __builtin_amdgcn_s_barrier(); asm volatile("" ::: "memory");
#define DA_LDK(sbp, hf_) do { _Pragma("unroll") for (int kt = 0; kt < 2; ++kt) _Pragma("unroll") for (int c = 0; c < 2; ++c) _Pragma("unroll") for (int ks = 0; ks < 2; ++ks) \
        kf[kt][c][ks] = *(const LAS bf16x8*)((sbp) + (32 * (hf_) + 16 * kt) * 256 + kfo[c][ks]); } while (0)
#define DA_LDB(k0_) do { _Pragma("unroll") for (int kt = 0; kt < 2; ++kt) _Pragma("unroll") for (int j = 0; j < 4; ++j) biasv[kt][j] = lutq[(k0_) + 16 * kt + j]; } while (0)
    bf16x8 kf[2][2][2]; f32x4 biasv[2];
    DA_LDK(stg, 0); DA_LDB(0);
    int s0 = 0;
    for (int t = 0; t < T; ++t) {
        const int s1 = s0 == 2 ? 0 : s0 + 1, s2 = s1 == 2 ? 0 : s1 + 1;
        if (t + 2 < T) DA_DMA(t + 2, s2);
        const LAS unsigned char* sb = stg + s0 * DA_STG;
#pragma unroll
        for (int hf = 0; hf < 2; ++hf) {
            f32x4 st[2][2];
#pragma unroll
            for (int kt = 0; kt < 2; ++kt)
#pragma unroll
                for (int c = 0; c < 2; ++c) { f32x4 z = MFMA16(kf[kt][c][0], qf[c][0], biasv[kt]); st[c][kt] = MFMA16(kf[kt][c][1], qf[c][1], z); }
            __builtin_amdgcn_sched_barrier(0);
            s16x4 v0[4], v1[4], w0[4], w1[4];
#pragma unroll
            for (int dt = 0; dt < 4; ++dt) { v0[dt] = *(const LAS s16x4*)(sb + dt * 2048 + vfo[hf][0]); v1[dt] = *(const LAS s16x4*)(sb + dt * 2048 + vfo[hf][1]); }
            if (hf == 0) DA_LDK(sb, 1);
            __builtin_amdgcn_sched_barrier(0);
#pragma unroll
            for (int kt = 0; kt < 2; ++kt)
#pragma unroll
                for (int j = 0; j < 4; ++j) { const float p0 = fexp2(st[0][kt][j]), p1 = fexp2(st[1][kt][j]); lsum0 += p0; lsum1 += p1; st[0][kt][j] = p0; st[1][kt][j] = p1; }
            bf16x8 pf[2];
#pragma unroll
            for (int c = 0; c < 2; ++c) { u32x4 w; w.x = cvt_pk_bf16(st[c][0][0], st[c][0][1]); w.y = cvt_pk_bf16(st[c][0][2], st[c][0][3]); w.z = cvt_pk_bf16(st[c][1][0], st[c][1][1]); w.w = cvt_pk_bf16(st[c][1][2], st[c][1][3]);
                pf[c] = __builtin_bit_cast(bf16x8, w); }
            __builtin_amdgcn_sched_barrier(0);
#pragma unroll
            for (int dt = 0; dt < 4; ++dt) { w0[dt] = *(const LAS s16x4*)(sb + (dt + 4) * 2048 + vfo[hf][0]); w1[dt] = *(const LAS s16x4*)(sb + (dt + 4) * 2048 + vfo[hf][1]); }
            if (hf == 0) DA_LDB(t * 64 + 32);
#pragma unroll
            for (int dt = 0; dt < 4; ++dt) { const bf16x8 vf = __builtin_shufflevector(v0[dt], v1[dt], 0, 1, 2, 3, 4, 5, 6, 7);
                o[0][dt] = MFMA16(vf, pf[0], o[0][dt]); o[1][dt] = MFMA16(vf, pf[1], o[1][dt]); }
            __builtin_amdgcn_sched_barrier(0);
#pragma unroll
            for (int dt = 0; dt < 4; ++dt) { const bf16x8 vf = __builtin_shufflevector(w0[dt], w1[dt], 0, 1, 2, 3, 4, 5, 6, 7);
                o[0][dt + 4] = MFMA16(vf, pf[0], o[0][dt + 4]); o[1][dt + 4] = MFMA16(vf, pf[1], o[1][dt + 4]); }
            __builtin_amdgcn_sched_barrier(0);
        }
        if (t + 2 < T) asm volatile("s_waitcnt vmcnt(4) lgkmcnt(0)" ::: "memory"); else asm volatile("s_waitcnt vmcnt(0) lgkmcnt(0)" ::: "memory");
        __builtin_amdgcn_s_barrier(); asm volatile("" ::: "memory");
        __builtin_amdgcn_sched_barrier(0);
        if (t + 1 < T) { DA_LDK(stg + s1 * DA_STG, 0); DA_LDB((t + 1) * 64); }
        s0 = s1;
    }
#undef DA_LDB
#undef DA_LDK
#undef DA_DMA
    lsum0 = quad_sum(lsum0, lane); lsum1 = quad_sum(lsum1, lane);
    const float* pt = (const float*)(ws + WS_PT) + l * PT_L;
    const float lam = pt[PT_LAM], lam_init = pt[PT_LAM + 1];
    const float i1 = 1.f / lsum0, i2 = lam / lsum1; float ssq = 0.f;
#pragma unroll
    for (int dt = 0; dt < 8; ++dt)
#pragma unroll
        for (int j = 0; j < 4; ++j) { const float v = o[0][dt][j] * i1 - o[1][dt][j] * i2; o[0][dt][j] = v; ssq += v * v; }
    ssq = quad_sum(ssq, lane);
    const float r = rsqrtf(ssq * (1.f / 128.f) + 1e-6f) * (1.f - lam_init);
    bf16_t* outp = (bf16_t*)(ws + WS_COUT) + ((size_t)(b << lgS) + q0 + ql) * 512 + h * 128 + 4 * quad;
    const float* sg = pt + PT_SUBG + 4 * quad;
#pragma unroll
    for (int dt = 0; dt < 8; ++dt) { const f32x4 g = *(const f32x4*)(sg + 16 * dt);
        *(u32x2*)(outp + 16 * dt) = (u32x2){cvt_pk_bf16(o[0][dt][0] * r * g[0], o[0][dt][1] * r * g[1]), cvt_pk_bf16(o[0][dt][2] * r * g[2], o[0][dt][3] * r * g[3])}; }
}

__device__ __forceinline__ void dilattn_item(unsigned char* ws, LAS unsigned char* lds, int lgS, int b, int sp, int j, int tid, int wave, int lane) {
    const int S = 1 << lgS;
    const int ql = lane & 15, quad = lane >> 4;
    const bf16_t* qkb = (const bf16_t*)(ws + WS_QK) + ((size_t)b << lgS) * QKP;
    bf16_t* bout = (bf16_t*)(ws + WS_BOUT) + ((size_t)b << lgS) * 384;
    float* lb = (float*)(ws + WS_LB) + ((size_t)j * MC + ((size_t)b << lgS)) * 4;
    const float* glut = (const float*)(ws + WS_LUT);
    LAS float* lutl = (LAS float*)lds;
#pragma unroll
    for (int i0 = 0; i0 < 3 * 4096; i0 += 512) { const int i = i0 + tid; lutl[i] = glut[(2 * (i >> 12) + j) * LUTN + LUTOFF - 2048 + (i & 4095)]; }
    __syncthreads();
    for (int uu = wave; uu < 48; uu += 8) {
        const int gi = uu >> 4, u = uu & 15, lg = 2 * gi, dil = 1 << lg, r = u & (dil - 1), n0 = (sp << (8 - lg)) + 16 * (u >> lg), L = S >> lg, hh = 2 * gi + j;
        const int tokq = ((n0 + ql) << lg) + r;
        bf16x8 qf[2];
#pragma unroll
        for (int ks = 0; ks < 2; ++ks) qf[ks] = *(const bf16x8*)(qkb + (size_t)(((((n0 >> 4) << lg) + r) << 4) + ql) * QKP + hh * 64 + 32 * ks + 8 * quad);
        f32x4 st[10];
#pragma unroll
        for (int kt = 0; kt < 10; ++kt) { int n = n0 - 64 + 32 * (kt >> 1) + 8 * (ql >> 2) + 4 * (kt & 1) + (ql & 3); n = n < 0 ? 0 : (n > L - 1 ? L - 1 : n);
            const bf16_t* kp = qkb + (size_t)(((((n >> 4) << lg) + r) << 4) + (n & 15)) * QKP + (6 + hh) * 64 + 8 * quad;
            const bf16x8 ka0 = *(const bf16x8*)kp, ka1 = *(const bf16x8*)(kp + 32);
            f32x4 z = (f32x4){0.f, 0.f, 0.f, 0.f}; z = MFMA16(ka0, qf[0], z); st[kt] = MFMA16(ka1, qf[1], z); }
        float lsum = 0.f;
        const LAS float* lutp = lutl + gi * 4096 + 2048;
#pragma unroll
        for (int kt = 0; kt < 10; ++kt)
#pragma unroll
            for (int e = 0; e < 4; ++e) { const int n = n0 - 64 + 32 * (kt >> 1) + 8 * quad + 4 * (kt & 1) + e, rel = n - (n0 + ql);
                const bool valid = (n >= 0) && (n < L) && (rel <= 64) && (rel >= -64);
                const float bias = lutp[rel * dil];
                const float p = valid ? fexp2(st[kt][e] + bias) : 0.f; lsum += p; st[kt][e] = p; }
        f32x4 o[4];
#pragma unroll
        for (int dt = 0; dt < 4; ++dt) o[dt] = (f32x4){0.f, 0.f, 0.f, 0.f};
        const bf16_t* vb = (const bf16_t*)(ws + WS_VTB) + ((size_t)(b * 384 + hh * 64 + ql) << lgS);
#pragma unroll
        for (int i = 0; i < 5; ++i) {
            u32x4 w; w.x = cvt_pk_bf16(st[2 * i][0], st[2 * i][1]); w.y = cvt_pk_bf16(st[2 * i][2], st[2 * i][3]); w.z = cvt_pk_bf16(st[2 * i + 1][0], st[2 * i + 1][1]); w.w = cvt_pk_bf16(st[2 * i + 1][2], st[2 * i + 1][3]);
            const bf16x8 pf = __builtin_bit_cast(bf16x8, w);
            int na = n0 - 64 + 32 * i + 8 * quad;
            na = na < 0 ? 0 : (na > L - 8 ? L - 8 : na);
#pragma unroll
            for (int dt = 0; dt < 4; ++dt) { const bf16_t* vp = vb + ((size_t)(dt * 16) << lgS);
                const bf16x8 vf = *(const bf16x8*)(vp + (((((na >> 4) << lg) + r) << 4) + (na & 15)));
                o[dt] = MFMA16(vf, pf, o[dt]); }
        }
        lsum = quad_sum(lsum, lane);
        bf16_t* op = bout + (size_t)tokq * 384 + hh * 64 + 4 * quad;
#pragma unroll
        for (int dt = 0; dt < 4; ++dt) *(u32x2*)(op + 16 * dt) = (u32x2){cvt_pk_bf16(o[dt][0], o[dt][1]), cvt_pk_bf16(o[dt][2], o[dt][3])};
        if (quad == 0) lb[(size_t)tokq * 4 + gi] = lsum;
    }
    asm volatile("s_waitcnt vmcnt(0)" ::: "memory"); __builtin_amdgcn_fence(__ATOMIC_SEQ_CST, "workgroup"); __syncthreads(); __builtin_amdgcn_fence(__ATOMIC_SEQ_CST, "workgroup");
    for (int idx = tid; idx < 256 * 24; idx += 512) {
        const int tok = sp * 256 + idx / 24, rem = idx % 24, gi = rem >> 3, piece = rem & 7, hh = 2 * gi + j;
        const float* lp = lb + (size_t)tok * 4;
        const float inv = 1.f / (lp[0] + lp[1] + lp[2]);
        u32x4* p = (u32x4*)(bout + (size_t)tok * 384 + hh * 64 + piece * 8); const u32x4 w = *p;
        u32x4 o; o.x = cvt_pk_bf16(bflo(w.x) * inv, bfhi(w.x) * inv); o.y = cvt_pk_bf16(bflo(w.y) * inv, bfhi(w.y) * inv); o.z = cvt_pk_bf16(bflo(w.z) * inv, bfhi(w.z) * inv); o.w = cvt_pk_bf16(bflo(w.w) * inv, bfhi(w.w) * inv);
        *p = o;
    }
    __syncthreads();
}

__device__ __forceinline__ void sgu_item(unsigned char* ws, LAS unsigned char* lds, int l, int ci, int tid, int wave, int lane) {
    const float* ptab = (const float*)(ws + WS_PT) + l * PT_L;
    typedef float f32x2 __attribute__((ext_vector_type(2)));
    LAS f32x2* stats = (LAS f32x2*)lds;
    LAS unsigned char* img = lds + 1024 + wave * 17408;
    const bf16_t* zv = (const bf16_t*)(ws + WS_ZV) + (size_t)ci * 128 * 512;
    const bf16_t* zu = (const bf16_t*)(ws + WS_ZU) + (size_t)ci * 128 * 512;
    bf16_t* aout = (bf16_t*)(ws + WS_AOUT) + (size_t)ci * 128 * 512;
#pragma unroll
    for (int t = 0; t < 16; ++t) { const int tok = wave * 16 + t;
        const u32x4 w = *(const u32x4*)(zv + (size_t)tok * 512 + lane * 8);
        float v[8] = {bflo(w.x), bfhi(w.x), bflo(w.y), bfhi(w.y), bflo(w.z), bfhi(w.z), bflo(w.w), bfhi(w.w)};
        float s = 0.f;
#pragma unroll
        for (int e = 0; e < 8; ++e) s += v[e];
        const float mean = wave_sum(s, lane) * (1.f / 512.f); float s2 = 0.f;
#pragma unroll
        for (int e = 0; e < 8; ++e) { const float d = v[e] - mean; s2 += d * d; }
        const float rstd = rsqrtf(wave_sum(s2, lane) * (1.f / 512.f) + 1e-5f);
        if (lane == 0) stats[tok] = (f32x2){mean, rstd}; }
    __syncthreads();
    const int g = wave;
    { const int tl = lane >> 3, cp = lane & 7; float gam[8], bet[8];
#pragma unroll
      for (int e = 0; e < 8; ++e) { gam[e] = ptab[PT_LNG + g * 64 + 8 * cp + e]; bet[e] = ptab[PT_LNB + g * 64 + 8 * cp + e]; }
#pragma unroll
      for (int it = 0; it < 16; ++it) { const int tok = 8 * it + tl; const f32x2 ms = stats[tok];
          const u32x4 w = *(const u32x4*)(zv + (size_t)tok * 512 + g * 64 + 8 * cp);
          float v[8] = {bflo(w.x), bfhi(w.x), bflo(w.y), bfhi(w.y), bflo(w.z), bfhi(w.z), bflo(w.w), bfhi(w.w)};
#pragma unroll
          for (int e = 0; e < 8; ++e) v[e] = (v[e] - ms[0]) * ms[1] * gam[e] + bet[e];
          LAS u32x2* d = (LAS u32x2*)(img + tok * 136 + cp * 16);
          d[0] = (u32x2){cvt_pk_bf16(v[0], v[1]), cvt_pk_bf16(v[2], v[3])}; d[1] = (u32x2){cvt_pk_bf16(v[4], v[5]), cvt_pk_bf16(v[6], v[7])}; } }
    __syncthreads();
    const int ql = lane & 15, quad = lane >> 4;
    typedef short v4i16_t __attribute__((ext_vector_type(4)));
    bf16x8 af[4][4];
#pragma unroll
    for (int dt = 0; dt < 4; ++dt)
#pragma unroll
        for (int ks = 0; ks < 4; ++ks) {
            const LAS unsigned char* p0 = img + (32 * ks + 8 * quad + (ql >> 2)) * 136 + 32 * dt + 8 * (ql & 3);
            const s16x4 t0 = __builtin_bit_cast(s16x4, __builtin_amdgcn_ds_read_tr16_b64_v4i16((LAS v4i16_t*)p0));
            const s16x4 t1 = __builtin_bit_cast(s16x4, __builtin_amdgcn_ds_read_tr16_b64_v4i16((LAS v4i16_t*)(p0 + 4 * 136)));
            af[dt][ks] = __builtin_shufflevector(t0, t1, 0, 1, 2, 3, 4, 5, 6, 7); }
    const bf16_t* wg = (const bf16_t*)(ws + WS_W + (size_t)l * WL + W_SGU) + (size_t)g * 128 * 128;
#pragma unroll 2
    for (int pt = 0; pt < 8; ++pt) {
        f32x4 acc[4];
#pragma unroll
        for (int dt = 0; dt < 4; ++dt) acc[dt] = (f32x4){0.f, 0.f, 0.f, 0.f};
#pragma unroll
        for (int ks = 0; ks < 4; ++ks) { const bf16x8 bfr = *(const bf16x8*)(wg + (size_t)(16 * pt + ql) * 128 + 32 * ks + 8 * quad);
#pragma unroll
            for (int dt = 0; dt < 4; ++dt) acc[dt] = MFMA16(af[dt][ks], bfr, acc[dt]); }
        const int tok = 16 * pt + ql; const float bias = ptab[PT_SGUB + g * 128 + tok];
#pragma unroll
        for (int dt = 0; dt < 4; ++dt) { const int col = g * 64 + 16 * dt + 4 * quad;
            const u32x2 uw = *(const u32x2*)(zu + (size_t)tok * 512 + col);
            *(u32x2*)(aout + (size_t)tok * 512 + col) = (u32x2){cvt_pk_bf16(bflo(uw.x) * (acc[dt][0] + bias), bfhi(uw.x) * (acc[dt][1] + bias)), cvt_pk_bf16(bflo(uw.y) * (acc[dt][2] + bias), bfhi(uw.y) * (acc[dt][3] + bias))}; }
    }
    __syncthreads();
}

#ifndef PHM
#define PHM 127
#endif
#ifndef IM
#define IM 7
#endif
#define GRID_SYNC() do { asm volatile("s_waitcnt vmcnt(0)" ::: "memory"); __syncthreads(); \
    grid.sync(); \
    if (threadIdx.x < 64) { __builtin_amdgcn_fence(__ATOMIC_ACQUIRE, "agent"); asm volatile("s_waitcnt vmcnt(0)" ::: "memory"); } __syncthreads(); } while (0)
__global__ void __launch_bounds__(512, 2) fwd(Args a) {
    extern __shared__ __attribute__((aligned(16))) unsigned char lds_raw[];
    LAS unsigned char* lds = (LAS unsigned char*)lds_raw;
    cg::grid_group grid = cg::this_grid();
    int s = a.lo;
    if (s == 0) {
        unsigned char* ws = a.ws; int tid = threadIdx.x, bx = blockIdx.x, G = gridDim.x;
        const int lane = tid & 63, wave = __builtin_amdgcn_readfirstlane(tid >> 6), gw = bx * 8 + wave, ngw = G * 8;
        if (PHM & 1) prologue(a, ws, lds, gw, ngw, wave, lane);
        ++s; if (s < a.hi) GRID_SYNC();
    }
#ifdef PROBE_P
    int probe_rep = 0;
#ifdef PROBE_IM
#define PROBE_SEL(x) (!probe_rep || (PROBE_IM & (x)))
#else
#define PROBE_SEL(x) true
#endif
#else
#define PROBE_SEL(x) true
#endif
    for (; s < a.hi; ++s) {
        size_t zo = 0; int bx = blockIdx.x, G = gridDim.x;
        asm volatile("" : "+s"(zo), "+s"(bx), "+s"(G));
        unsigned char* ws = a.ws + zo;
        const int t = s - 1, c = t / 24, l = (t % 24) / 6, p = t % 6;
        const int lgS = c < 2 ? 11 : 12;
        unsigned char* wl = ws + WS_W + (size_t)l * WL;
        const size_t xbo = (c & 1) ? WS_XB2 : WS_XB, xbn = (c & 1) ? WS_XB : WS_XB2;
        if (p == 0 && (PHM & 2)) {
            pg8::Gemm g{(const bf16_t*)(ws + xbo), (const bf16_t*)(wl + W_IN), MC, ZN, 1024}; pg8::StaticOrder S; S.init(MC, ZN, G, bx);
            EpiWin E{ws, l, lgS, (LAS float*)(lds + 131072)};
            pg8::gemm_phase<EpiWin, pg8::StaticOrder, true, true>(lds, g, S, E);
        } else if (p == 1 && (PHM & 4)) {
            int tid = threadIdx.x; asm volatile("" : "+v"(tid));
            const int lane = tid & 63, wave = __builtin_amdgcn_readfirstlane(tid >> 6);
            const int nqb = (1 << lgS) / 128, NC = (MC / 128) * 4, NB = (MC / 256) * 2, NA = MC / 128;
            {
            const int vbx = (G & 7) == 0 ? (bx & 7) * (G >> 3) + (bx >> 3) : bx;
            if ((IM & 1) && PROBE_SEL(1)) for (int it = vbx; it < NC; it += G) { const int qb = it % nqb, bh = it / nqb; diffattn_item(ws, lds, l, lgS, bh >> 2, bh & 3, qb, tid, wave, lane); }
            if ((IM & 2) && PROBE_SEL(2)) for (int it = bx; it < NB; it += G) { const int j = it & 1, gsp = it >> 1, nsp = (1 << lgS) / 256; dilattn_item(ws, lds, lgS, gsp / nsp, gsp % nsp, j, tid, wave, lane); }
            if ((IM & 4) && PROBE_SEL(4)) for (int it = bx; it < NA; it += G) sgu_item(ws, lds, l, it, tid, wave, lane);
            }
        } else if (p == 2 && (PHM & 8)) {
            pg8::StaticOrder S; S.init(MC, 1024, G, bx);
#pragma nounroll
            for (int br = 0; br < 3; ++br) {
                const size_t aoff = br == 0 ? WS_AOUT : br == 1 ? WS_BOUT : WS_COUT, woff = br == 0 ? W_PA : br == 1 ? W_PB : W_PC;
                pg8::Gemm g{(const bf16_t*)(ws + aoff), (const bf16_t*)(wl + woff), MC, 1024, br == 1 ? 384 : 512}; EpiWp E{ws, br};
                pg8::gemm_phase<EpiWp, pg8::StaticOrder, true, true>(lds, g, S, E);
            }
        } else if ((p == 3 && (PHM & 16)) || (p == 5 && (PHM & 64))) {
            float* xout = a.out + (size_t)c * MC * 1024 + zo;
            const bool wo = p == 3;
            pg8::Gemm g{(const bf16_t*)(ws + (wo ? WS_MERGED : WS_HID)), (const bf16_t*)(wl + (wo ? W_O : W_DN)), MC, 1024, wo ? 1024 : DFF}; pg8::StaticOrder S; S.init(MC, 1024, G, bx);
            EpiRes E{xout, (bf16_t*)(ws + xbo), (float*)(ws + (wo ? WS_SS2 : WS_SS1)), (wo || l < DEPTH - 1) ? 1 : 0};
            pg8::gemm_phase<EpiRes, pg8::StaticOrder, true, true>(lds, g, S, E);
            if (!wo && l == DEPTH - 1 && c + 1 < NCHUNK) {
                int tid = threadIdx.x; asm volatile("" : "+v"(tid));
                const int lane = tid & 63, wave = __builtin_amdgcn_readfirstlane(tid >> 6);
                const float* xn = ((c + 1) < 2 ? a.in[I_XP] + (size_t)(c + 1) * MC * 1024 : a.in[I_XS]) + zo;
                prep_chunk(xn, (bf16_t*)(ws + xbn), (float*)(ws + WS_SS1), bx * 8 + wave, G * 8, lane);
            }
        } else if (p == 4 && (PHM & 32)) {
            pg8::Gemm g{(const bf16_t*)(ws + xbo), (const bf16_t*)(wl + W_GU), MC, 2 * DFF, 1024}; pg8::StaticOrder S; S.init(MC, 2 * DFF, G, bx);
            EpiGu E{(const float*)(ws + WS_SS2), (bf16_t*)(ws + WS_HID), (LAS float*)(lds + 131072)};
            pg8::gemm_phase<EpiGu, pg8::StaticOrder, true, true>(lds, g, S, E);
        }
        if (s + 1 < a.hi) GRID_SYNC();
#ifdef PROBE_P
        if (p == PROBE_P && !probe_rep) { probe_rep = 1; --s; } else probe_rep = 0;
#endif
    }
}

#ifndef MK_MULTI
#define MK_MULTI 0
#endif
extern "C" void kernel_launch(void* const* d_in, const int* in_sizes, int n_in, void* d_out, int out_size, void* d_ws, size_t ws_size, hipStream_t stream) {
    static int grid = 0;
    if (grid == 0) {
        if (n_in != 25 || ws_size < WS_END) { fprintf(stderr, "kernel_launch: need 25 inputs and %zu bytes of workspace (got %d, %zu)\n", (size_t)WS_END, n_in, ws_size); grid = -1; return; }
        int dev = 0, cus = 0, per_cu = 0;
        if (hipGetDevice(&dev) != hipSuccess || hipDeviceGetAttribute(&cus, hipDeviceAttributeMultiprocessorCount, dev) != hipSuccess) { grid = -1; return; }
        if (hipFuncSetAttribute((const void*)fwd, hipFuncAttributeMaxDynamicSharedMemorySize, LDS_BYTES) != hipSuccess) { fprintf(stderr, "kernel_launch: hipFuncSetAttribute failed\n"); grid = -1; return; }
        if (hipOccupancyMaxActiveBlocksPerMultiprocessor(&per_cu, (const void*)fwd, 512, LDS_BYTES) != hipSuccess || per_cu < 1) per_cu = 1;
        (void)hipGetLastError();
        grid = cus * per_cu;
        fprintf(stderr, "kernel_launch: grid %d (%d CUs x %d), ws %zu\n", grid, cus, per_cu, ws_size);
    }
    if (grid < 0) return;
    Args a{};
    for (int i = 0; i < 25; ++i) a.in[i] = (const float*)d_in[i];
    a.out = (float*)d_out; a.ws = (unsigned char*)d_ws;
#if MK_MULTI
    for (int s = 0; s < NSTEPS; ++s) { a.lo = s; a.hi = s + 1; void* args[] = {&a};
        hipError_t e = hipLaunchCooperativeKernel((const void*)fwd, dim3(grid), dim3(512), args, LDS_BYTES, stream);
        if (e != hipSuccess) { fprintf(stderr, "kernel_launch: launch %d failed: %s\n", s, hipGetErrorString(e)); break; } }
#else
    a.lo = 0; a.hi = NSTEPS; void* args[] = {&a};
    hipError_t e = hipLaunchCooperativeKernel((const void*)fwd, dim3(grid), dim3(512), args, LDS_BYTES, stream);
    if (e != hipSuccess) fprintf(stderr, "kernel_launch: cooperative launch failed: %s (grid %d)\n", hipGetErrorString(e), grid);
#endif
}
```

```cpp
#include <hip/hip_runtime.h>
#include <hip/hip_cooperative_groups.h>
#include <cstdio>
#include <cstdint>
namespace cg = cooperative_groups;
namespace pg8 {
#define PG8_LAS __attribute__((address_space(3)))
typedef unsigned short bf16_t;
typedef short bf16x8 __attribute__((ext_vector_type(8)));
typedef float f32x4 __attribute__((ext_vector_type(4)));
typedef unsigned u32x4 __attribute__((ext_vector_type(4)));
constexpr int BM = 256, BK = 64, HALF = 128, HTB = HALF * BK * 2  , STAGE_BYTES = 8 * HTB, NXCD = 8, WGM = 8;

__host__ __device__ __forceinline__ int lds_byte(int r, int c) { const int st = (r >> 4) * 2 + (c >> 5), rr = r & 15, cc = c & 31, ob = rr * 64 + cc * 2; return st * 1024 + (ob ^ (((ob >> 9) & 1) << 5)); }
__host__ __device__ __forceinline__ void stage_rc(int b, int& R, int& C) { const int st = b / 1024, sb = b % 1024, swz = sb ^ (((sb >> 9) & 1) << 5); R = (st >> 1) * 16 + swz / 64; C = (st & 1) * 32 + (swz % 64) / 2; }
__host__ __device__ __forceinline__ int perm32(int rho) { const int n = rho >> 4, i = rho & 15; return 8 * (i >> 2) + 4 * n + (i & 3); }

struct Unit { int pm, pn; };
struct Gemm { const bf16_t* A; const bf16_t* Bt; int M, N, K; };

struct StaticOrder {
    int nM, nN, nwg, G, c;
    __host__ __device__ void init(int M, int N, int G_, int c_) { nM = M / BM; nN = N / BM; nwg = nM * nN; G = G_; c = c_; }
    __host__ __device__ bool next(int i, Unit& u) const {
        const long L = (long)i * G + c; if (L >= nwg) return false;
        int wgid = (int)L; { const int q = nwg / NXCD, r = nwg % NXCD, xcd = wgid % NXCD, off = wgid / NXCD; wgid = (xcd < r ? xcd * (q + 1) : r * (q + 1) + (xcd - r) * q) + off; }
        const int nig = WGM * nN, gid = wgid / nig, fm = gid * WGM, gsz = (nM - fm) < WGM ? (nM - fm) : WGM;
        u.pm = fm + ((wgid % nig) % gsz); u.pn = (wgid % nig) / gsz; return true;
    }
    __device__ __forceinline__ void a_ready(const Unit&) const {}
    __device__ __forceinline__ void done(const Unit&) const {}
};

__device__ __forceinline__ unsigned cvt_pk_bf16(float lo, float hi) { unsigned r; asm volatile("v_cvt_pk_bf16_f32 %0, %1, %2" : "=v"(r) : "v"(lo), "v"(hi)); return r; }
template <class Epi, class Sched, bool ALIGN_EPI = false, bool SP2 = false>
__device__ __forceinline__ void gemm_phase(PG8_LAS unsigned char* lds, const Gemm g, const Sched& S, const Epi& E) {
    int tid_ = threadIdx.x; asm volatile("" : "+v"(tid_));
    const int tid = tid_, wid = __builtin_amdgcn_readfirstlane(tid >> 6), lane = tid & 63, wr = wid >> 2, wc = wid & 3, fr = lane & 15, fq = lane >> 4;
    const int K = g.K, nt = K / BK;
    unsigned voffA[2], voffB[2];
#pragma unroll
    for (int i = 0; i < 2; ++i) { int R, C; stage_rc(tid * 16 + i * 8192, R, C); const int Rb = Epi::PERM ? ((R & ~31) + perm32(R & 31)) : R;
        voffA[i] = (unsigned)(R * K + C) * 2u; voffB[i] = (unsigned)(Rb * K + C) * 2u; }
    const size_t kstep = (size_t)(BK * 2);
    const size_t hstep = (size_t)HALF * K * 2;
    const size_t tstep = 2 * hstep;
    const unsigned ldsw = (unsigned)wid * 1024u;
    const int aoff = lds_byte(wr * 64 + fr, fq * 8), boff = lds_byte(wc * 32 + fr, fq * 8);
#define PG8_SA(b, h) (((b) * 2 + (h)) * HTB)
#define PG8_SB(b, h) ((4 + (b) * 2 + (h)) * HTB)
#define PG8_STAGE(bufoff, gbase, voff) do { _Pragma("unroll") for (int _i = 0; _i < 2; ++_i) \
        __builtin_amdgcn_global_load_lds((const unsigned*)((const char*)(gbase) + (voff)[_i]), (PG8_LAS unsigned*)(lds + (bufoff) + ldsw + _i * 8192), 16, 0, 0); } while (0)
#define PG8_LDA(dst, b, h) do { _Pragma("unroll") for (int m = 0; m < 4; ++m) _Pragma("unroll") for (int k = 0; k < 2; ++k) dst[m][k] = *(const PG8_LAS bf16x8*)(lds + PG8_SA(b, h) + aoff + m * 2048 + k * 1024); } while (0)
#define PG8_LDB(dst, b, h) do { _Pragma("unroll") for (int n = 0; n < 2; ++n) _Pragma("unroll") for (int k = 0; k < 2; ++k) dst[n][k] = *(const PG8_LAS bf16x8*)(lds + PG8_SB(b, h) + boff + n * 2048 + k * 1024); } while (0)
#define PG8_MMA(ai, bj, At, Bt) do { __builtin_amdgcn_s_setprio(1); _Pragma("unroll") for (int m = 0; m < 4; ++m) _Pragma("unroll") for (int n = 0; n < 2; ++n) _Pragma("unroll") for (int k = 0; k < 2; ++k) \
        acc[ai][bj][m][n] = __builtin_amdgcn_mfma_f32_16x16x32_bf16(Bt[n][k], At[m][k], acc[ai][bj][m][n], 0, 0, 0); __builtin_amdgcn_s_setprio(0); } while (0)
#define PG8_WAIT_V(n) asm volatile("s_waitcnt vmcnt(" #n ")" ::: "memory")
#define PG8_WAIT_L(n) asm volatile("s_waitcnt lgkmcnt(" #n ")" ::: "memory")
#define PG8_BAR __builtin_amdgcn_s_barrier()
#define PG8_SCHED __builtin_amdgcn_sched_barrier(0)
    Unit cur, nxt; int ui = 0;
    if (!S.next(0, cur)) return;
    f32x4 acc[2][2][4][2];
#pragma unroll
    for (int a = 0; a < 2; ++a)
#pragma unroll
        for (int b = 0; b < 2; ++b)
#pragma unroll
            for (int m = 0; m < 4; ++m)
#pragma unroll
                for (int n = 0; n < 2; ++n) acc[a][b][m][n] = (f32x4){0.f, 0.f, 0.f, 0.f};
    bf16x8 At[4][2], B0[2][2], B1[2][2];
    const char* cA = (const char*)g.A + (size_t)cur.pm * tstep; const char* cB = (const char*)g.Bt + (size_t)cur.pn * tstep;
    S.a_ready(cur);
    if constexpr (SP2) {
        PG8_STAGE(PG8_SB(0, 0), cB, voffB); PG8_STAGE(PG8_SB(0, 1), cB + hstep, voffB); PG8_STAGE(PG8_SA(0, 0), cA, voffA); PG8_STAGE(PG8_SA(0, 1), cA + hstep, voffA);
        if (wr == 1) PG8_BAR;
        PG8_WAIT_V(2); PG8_BAR;
        PG8_STAGE(PG8_SB(1, 0), cB + kstep, voffB); PG8_STAGE(PG8_SA(1, 0), cA + kstep, voffA); PG8_STAGE(PG8_SB(1, 1), cB + hstep + kstep, voffB);
        PG8_WAIT_V(6); PG8_BAR;
    } else {
        PG8_STAGE(PG8_SB(0, 0), cB, voffB); PG8_STAGE(PG8_SA(0, 0), cA, voffA); PG8_STAGE(PG8_SB(0, 1), cB + hstep, voffB); PG8_STAGE(PG8_SA(0, 1), cA + hstep, voffA);
        if (wr == 1) PG8_BAR;
        PG8_WAIT_V(4); PG8_BAR;
        PG8_STAGE(PG8_SB(1, 0), cB + kstep, voffB); PG8_STAGE(PG8_SA(1, 0), cA + kstep, voffA); PG8_STAGE(PG8_SB(1, 1), cB + hstep + kstep, voffB);
        PG8_WAIT_V(6); PG8_BAR;
    }
    for (;;) {
        const bool has_next = S.next(ui + 1, nxt);
        const char* nA = has_next ? (const char*)g.A + (size_t)nxt.pm * tstep : cA; const char* nB = has_next ? (const char*)g.Bt + (size_t)nxt.pn * tstep : cB;
        for (int t = 0; t < nt; t += 2) {
            const bool last = (t == nt - 2);
            const char* a1 = cA + (size_t)(t + 1) * kstep;
            const char* a2 = last ? nA : cA + (size_t)(t + 2) * kstep; const char* b2 = last ? nB : cB + (size_t)(t + 2) * kstep;
            const char* a3 = a2 + kstep; const char* b3 = b2 + kstep;
            if (last && has_next) S.a_ready(nxt);
            if constexpr (SP2) {
            PG8_LDB(B0, 0, 0); PG8_LDB(B1, 0, 1); PG8_SCHED; PG8_LDA(At, 0, 0); PG8_STAGE(PG8_SA(1, 1), a1 + hstep, voffA);
            PG8_WAIT_V(8); PG8_WAIT_L(0); PG8_BAR; PG8_MMA(0, 0, At, B0); PG8_MMA(0, 1, At, B1); PG8_BAR; PG8_SCHED;
            PG8_LDA(At, 0, 1); PG8_STAGE(PG8_SB(0, 0), b2, voffB); PG8_STAGE(PG8_SB(0, 1), b2 + hstep, voffB); PG8_STAGE(PG8_SA(0, 0), a2, voffA);
            PG8_WAIT_V(8); PG8_WAIT_L(0); PG8_BAR; PG8_MMA(1, 0, At, B0); PG8_MMA(1, 1, At, B1); PG8_BAR; PG8_SCHED;
            PG8_LDB(B0, 1, 0); PG8_LDB(B1, 1, 1); PG8_SCHED; PG8_LDA(At, 1, 0); PG8_STAGE(PG8_SA(0, 1), a2 + hstep, voffA);
            PG8_WAIT_V(8); PG8_WAIT_L(0); PG8_BAR; PG8_MMA(0, 0, At, B0); PG8_MMA(0, 1, At, B1); PG8_BAR; PG8_SCHED;
            PG8_LDA(At, 1, 1); PG8_STAGE(PG8_SB(1, 0), b3, voffB); PG8_STAGE(PG8_SB(1, 1), b3 + hstep, voffB); PG8_STAGE(PG8_SA(1, 0), a3, voffA);
            PG8_WAIT_V(8); PG8_WAIT_L(0); PG8_BAR; PG8_MMA(1, 0, At, B0); PG8_MMA(1, 1, At, B1); PG8_BAR; PG8_SCHED;
            } else {
            PG8_LDB(B0, 0, 0); PG8_SCHED; PG8_LDA(At, 0, 0); PG8_STAGE(PG8_SA(1, 1), a1 + hstep, voffA);
            PG8_WAIT_L(8); PG8_BAR; PG8_WAIT_L(0); PG8_MMA(0, 0, At, B0); PG8_BAR; PG8_SCHED;
            PG8_LDB(B1, 0, 1); PG8_STAGE(PG8_SB(0, 0), b2, voffB);
            PG8_BAR; PG8_WAIT_L(0); PG8_MMA(0, 1, At, B1); PG8_BAR;
            PG8_LDA(At, 0, 1); PG8_STAGE(PG8_SA(0, 0), a2, voffA);
            PG8_BAR; PG8_WAIT_L(0); PG8_MMA(1, 0, At, B0); PG8_BAR; PG8_SCHED;
            PG8_STAGE(PG8_SB(0, 1), b2 + hstep, voffB);
            PG8_WAIT_V(6); PG8_BAR; PG8_MMA(1, 1, At, B1); PG8_BAR;
            PG8_LDB(B0, 1, 0); PG8_SCHED; PG8_LDA(At, 1, 0); PG8_STAGE(PG8_SA(0, 1), a2 + hstep, voffA);
            PG8_WAIT_L(8); PG8_BAR; PG8_WAIT_L(0); PG8_MMA(0, 0, At, B0); PG8_BAR; PG8_SCHED;
            PG8_LDB(B1, 1, 1); PG8_STAGE(PG8_SB(1, 0), b3, voffB);
            PG8_BAR; PG8_WAIT_L(0); PG8_MMA(0, 1, At, B1); PG8_BAR;
            PG8_LDA(At, 1, 1); PG8_STAGE(PG8_SA(1, 0), a3, voffA);
            PG8_BAR; PG8_WAIT_L(0); PG8_MMA(1, 0, At, B0); PG8_BAR; PG8_SCHED;
            PG8_STAGE(PG8_SB(1, 1), b3 + hstep, voffB);
            PG8_WAIT_V(6); PG8_BAR; PG8_MMA(1, 1, At, B1); PG8_BAR;
            }
        }
        if constexpr (ALIGN_EPI) { if (wr == 0) PG8_BAR; }
        if constexpr (!Epi::AFTER_DRAIN) { E(acc, cur, wr, wc, fr, fq); S.done(cur); }
        if (!has_next) break;
#pragma unroll
        for (int a = 0; a < 2; ++a)
#pragma unroll
            for (int b = 0; b < 2; ++b)
#pragma unroll
                for (int m = 0; m < 4; ++m)
#pragma unroll
                    for (int n = 0; n < 2; ++n) acc[a][b][m][n] = (f32x4){0.f, 0.f, 0.f, 0.f};
        cur = nxt; cA = nA; cB = nB; ++ui;
        if constexpr (ALIGN_EPI) { if (wr == 1) PG8_BAR; }
    }
    PG8_WAIT_V(0);
    if constexpr (!ALIGN_EPI) { if (wr == 0) PG8_BAR; }
    PG8_BAR;
    if constexpr (Epi::AFTER_DRAIN) { E.fused(acc, cur, wr, wc, fr, fq, lds, wid, lane); S.done(cur); }
#undef PG8_SA
#undef PG8_SB
#undef PG8_STAGE
#undef PG8_LDA
#undef PG8_LDB
#undef PG8_MMA
#undef PG8_WAIT_V
#undef PG8_WAIT_L
#undef PG8_BAR
#undef PG8_SCHED
}
}

using pg8::bf16_t; using pg8::bf16x8; using pg8::f32x4; using pg8::u32x4; using pg8::Unit;
typedef __bf16 bf16x2_t __attribute__((ext_vector_type(2)));
typedef float f32x2_t __attribute__((ext_vector_type(2)));
__device__ __forceinline__ unsigned cvt_pk_bf16(float lo, float hi) { const f32x2_t v = {lo, hi}; const bf16x2_t b = __builtin_convertvector(v, bf16x2_t); return __builtin_bit_cast(unsigned, b); }
typedef short s16x4 __attribute__((ext_vector_type(4)));
typedef unsigned u32x2 __attribute__((ext_vector_type(2)));
#define LAS __attribute__((address_space(3)))
constexpr int DM = 1024, DEPTH = 4, DFF = 2816, ZN = 6912, INC = 6784;
constexpr int MC = 32768;
constexpr int NCHUNK = 3;
constexpr int NQKH = 28, QKP = NQKH * 64;
constexpr float LOG2E = 1.4426950408889634f;
constexpr int LUTN = 8192, LUTOFF = 4096;
constexpr size_t MiB = 1u << 20;
constexpr size_t WS_LUT = 0, WS_GT = 512 * 1024, WS_PT = 768 * 1024, WS_W = 1 * MiB, WL = 35 * MiB;
constexpr size_t W_IN = 0, W_PA = 14155776, W_PB = 15204352, W_PC = 15990784, W_O = 17039360, W_GU = 19136512, W_DN = 30670848, W_SGU = 36438016;
static_assert(W_SGU + 8 * 128 * 128 * 2 == WL, "weight map");
constexpr size_t WS_XB = 141 * MiB, WS_ZU = 205 * MiB, WS_ZV = 237 * MiB, WS_QK = 269 * MiB, WS_VTB = 381 * MiB, WS_VTC = 405 * MiB, WS_GATE = 437 * MiB;
constexpr size_t WS_AOUT = 629 * MiB, WS_BOUT = 661 * MiB, WS_COUT = 685 * MiB, WS_MERGED = 717 * MiB, WS_SS1 = 781 * MiB, WS_SS2 = 783 * MiB, WS_LB = 785 * MiB, WS_XB2 = 786 * MiB, WS_END = 850 * MiB;
constexpr size_t WS_MF32 = WS_QK, WS_HID = WS_GATE;
static_assert(WS_W + 4 * WL == WS_XB && WS_QK + (size_t)MC * QKP * 2 == WS_VTB && WS_VTB + (size_t)MC * 384 * 2 == WS_VTC && WS_VTC + (size_t)MC * 512 * 2 == WS_GATE, "ws map");
static_assert(WS_MF32 + (size_t)MC * 1024 * 4 <= WS_GATE && WS_HID + (size_t)MC * DFF * 2 <= WS_AOUT && WS_GATE + (size_t)MC * 3072 * 2 == WS_AOUT, "ws alias map");
constexpr int PT_L = 4096, PT_SUBG = 0, PT_LNG = 128, PT_LNB = 640, PT_SGUB = 1152, PT_LAM = 2176;
constexpr int LDS_BYTES = 147456;
constexpr int NSTEPS = 1 + NCHUNK * DEPTH * 6;

struct Args { const float* in[25]; float* out; unsigned char* ws; int lo, hi; };
enum { I_XP = 0, I_XS, I_RELB, I_N1G, I_WIN, I_LNG, I_LNB, I_SGUW, I_SGUB, I_QNB, I_KNB, I_QNC, I_KNC, I_LQ1, I_LK1, I_LQ2, I_LK2, I_SUBG, I_WPA, I_WPB, I_WPC, I_WO, I_N2G, I_WGU, I_WDN };

__device__ __forceinline__ float bflo(unsigned w) { return __uint_as_float(w << 16); }
__device__ __forceinline__ float bfhi(unsigned w) { return __uint_as_float(w & 0xffff0000u); }
__device__ __forceinline__ float fexp2(float x) { return __builtin_amdgcn_exp2f(x); }
__device__ __forceinline__ float frcp(float x) { return __builtin_amdgcn_rcpf(x); }
__device__ __forceinline__ float sigmoidf_(float x) { return frcp(1.f + fexp2(-LOG2E * x)); }
__device__ __forceinline__ float gelu_tanh(float x) { const float u = 0.7978845608028654f * (x + 0.044715f * x * x * x); return x * frcp(1.f + fexp2(-2.f * LOG2E * u)); }
__device__ __forceinline__ float shx(float v, int lane, int o) { return __builtin_bit_cast(float, __builtin_amdgcn_ds_bpermute((lane ^ o) << 2, __builtin_bit_cast(int, v))); }
__device__ __forceinline__ float wave_sum(float v, int lane) {
#pragma unroll
    for (int o = 1; o < 64; o <<= 1) v += shx(v, lane, o);
    return v;
}
__device__ __forceinline__ float quad_sum(float v, int lane) { v += shx(v, lane, 16); v += shx(v, lane, 32); return v; }
__device__ __forceinline__ unsigned cvt_pk_asm(float lo, float hi) { unsigned r; asm volatile("s_nop 1\n\tv_cvt_pk_bf16_f32 %0, %1, %2" : "=v"(r) : "v"(lo), "v"(hi)); return r; }
__device__ __forceinline__ u32x4 pack8(const float* v) { u32x4 w; w.x = cvt_pk_asm(v[0], v[1]); w.y = cvt_pk_asm(v[2], v[3]); w.z = cvt_pk_asm(v[4], v[5]); w.w = cvt_pk_asm(v[6], v[7]); return w; }
__device__ __forceinline__ float ss_total(const float* ssp, size_t row) {
    float t = 0.f;
#pragma unroll
    for (int pn = 0; pn < 4; ++pn) { const f32x4 v = *(const f32x4*)(ssp + ((size_t)pn * MC + row) * 4); t += (v[0] + v[1]) + (v[2] + v[3]); }
    return t;
}
__device__ __forceinline__ void unit_row_scales(float (&rs)[2][4], const float* ssp, LAS float* rsb, int pm, int wr, int wc, int fr, int fq) {
    const int t = (wr * 4 + wc) * 64 + fq * 16 + fr;
    if (t < 256) rsb[t] = rsqrtf(ss_total(ssp, (size_t)pm * 256 + t) * (1.f / 1024.f) + 1e-6f);
    asm volatile("s_waitcnt lgkmcnt(0)" ::: "memory"); __builtin_amdgcn_s_barrier(); asm volatile("" ::: "memory");
#pragma unroll
    for (int ai = 0; ai < 2; ++ai)
#pragma unroll
        for (int m = 0; m < 4; ++m) rs[ai][m] = rsb[ai * 128 + wr * 64 + m * 16 + fr];
}
#define MFMA16(a, b, c) __builtin_amdgcn_mfma_f32_16x16x32_bf16((a), (b), (c), 0, 0, 0)

struct EpiWin {
    static constexpr bool PERM = true, AFTER_DRAIN = false;
    unsigned char* ws; int l, lgS; LAS float* rsb;
    __device__ __forceinline__ void operator()(const f32x4 (&acc)[2][2][4][2], const Unit& u, int wr, int wc, int fr, int fq) const {
        const int row0 = u.pm * 256 + wr * 64 + fr, pn = u.pn;
        const float* ss1 = (const float*)(ws + WS_SS1);
        float rs[2][4];
        unit_row_scales(rs, ss1, rsb, u.pm, wr, wc, fr, fq);
        if (pn < 4) {
            bf16_t* base = (bf16_t*)(ws + (pn < 2 ? WS_ZU : WS_ZV)) + (pn & 1) * 256 + wc * 32 + 8 * fq;
#pragma unroll
            for (int ai = 0; ai < 2; ++ai)
#pragma unroll
                for (int m = 0; m < 4; ++m) { const size_t row = row0 + ai * 128 + m * 16;
#pragma unroll
                    for (int bj = 0; bj < 2; ++bj) { float v[8];
#pragma unroll
                        for (int e = 0; e < 8; ++e) v[e] = gelu_tanh(acc[ai][bj][m][e >> 2][e & 3] * rs[ai][m]);
                        *(u32x4*)(base + row * 512 + bj * 128) = pack8(v); } __builtin_amdgcn_sched_barrier(0); }
        } else if (pn < 11) {
            const int hh = 4 * (pn - 4) + wc;
            const float* gp = (const float*)(ws + WS_GT) + (l * NQKH + hh) * 64;
            float g[2][8];
#pragma unroll
            for (int bj = 0; bj < 2; ++bj)
#pragma unroll
                for (int e = 0; e < 8; ++e) g[bj][e] = gp[32 * bj + 8 * fq + e];
            bf16_t* base = (bf16_t*)(ws + WS_QK) + hh * 64 + 8 * fq;
#pragma unroll
            for (int ai = 0; ai < 2; ++ai)
#pragma unroll
                for (int m = 0; m < 4; ++m) { const int rown = row0 + ai * 128 + m * 16; float ssq = 0.f;
                    size_t row = rown;
                    if (hh < 12) { const int lgd = 2 * ((hh < 6 ? hh : hh - 6) >> 1), s = rown & ((1 << lgS) - 1), nn = s >> lgd; row = (size_t)(rown - s) + ((((nn >> 4) << lgd) + (s & ((1 << lgd) - 1))) << 4) + (nn & 15); }
#pragma unroll
                    for (int bj = 0; bj < 2; ++bj)
#pragma unroll
                        for (int e = 0; e < 8; ++e) { const float t = acc[ai][bj][m][e >> 2][e & 3] * rs[ai][m]; ssq += t * t; }
                    ssq = quad_sum(ssq, fq * 16 + fr);
                    const float r = rsqrtf(ssq * (1.f / 64.f) + 1e-6f) * rs[ai][m];
#pragma unroll
                    for (int bj = 0; bj < 2; ++bj) { float v[8];
#pragma unroll
                        for (int e = 0; e < 8; ++e) v[e] = acc[ai][bj][m][e >> 2][e & 3] * r * g[bj][e];
                        *(u32x4*)(base + row * QKP + 32 * bj) = pack8(v); } __builtin_amdgcn_sched_barrier(0); }
        } else if (pn < 15) {
            const int S = 1 << lgS;
#pragma unroll
            for (int bj = 0; bj < 2; ++bj) {
                const int vch0 = (pn - 11) * 256 + 128 * bj + 32 * wc + 8 * fq;
                if (vch0 >= 896) continue;
                const bool isB = vch0 < 384; const int lg = isB ? 2 * (vch0 >> 7) : 0;
#pragma unroll
                for (int ai = 0; ai < 2; ++ai)
#pragma unroll
                    for (int m = 0; m < 4; ++m) { const int row = row0 + ai * 128 + m * 16; const int b = row >> lgS, s = row & (S - 1);
                        const int nn = s >> lg, idx = ((((nn >> 4) << lg) + (s & ((1 << lg) - 1))) << 4) + (nn & 15);
                        bf16_t* dst = isB ? (bf16_t*)(ws + WS_VTB) + ((size_t)(b * 384 + vch0) << lgS) + idx : (bf16_t*)(ws + WS_VTC) + ((size_t)(b * 512 + vch0 - 384) << lgS) + s;
#pragma unroll
                        for (int e = 0; e < 8; e += 2) { const unsigned w = cvt_pk_asm(acc[ai][bj][m][e >> 2][e & 3] * rs[ai][m], acc[ai][bj][m][e >> 2][(e & 3) + 1] * rs[ai][m]);
                            dst[(size_t)e << lgS] = (bf16_t)(w & 0xffffu); dst[(size_t)(e + 1) << lgS] = (bf16_t)(w >> 16); } __builtin_amdgcn_sched_barrier(0); }
            }
        } else {
            bf16_t* base = (bf16_t*)(ws + WS_GATE) + (pn - 15) * 256 + wc * 32 + 8 * fq;
#pragma unroll
            for (int ai = 0; ai < 2; ++ai)
#pragma unroll
                for (int m = 0; m < 4; ++m) { const size_t row = row0 + ai * 128 + m * 16;
#pragma unroll
                    for (int bj = 0; bj < 2; ++bj) { float v[8];
#pragma unroll
                        for (int e = 0; e < 8; ++e) v[e] = sigmoidf_(acc[ai][bj][m][e >> 2][e & 3] * rs[ai][m]);
                        *(u32x4*)(base + row * 3072 + bj * 128) = pack8(v); } __builtin_amdgcn_sched_barrier(0); }
        }
    }
};
struct EpiWp {
    static constexpr bool PERM = true, AFTER_DRAIN = false;
    unsigned char* ws; int BR;
    __device__ __forceinline__ void operator()(const f32x4 (&acc)[2][2][4][2], const Unit& u, int wr, int wc, int fr, int fq) const {
        const int row0 = u.pm * 256 + wr * 64 + fr, col0 = u.pn * 256 + wc * 32 + 8 * fq;
        const bf16_t* gate = (const bf16_t*)(ws + WS_GATE); bf16_t* merged = (bf16_t*)(ws + WS_MERGED);
        u32x4 gwv[2][4][2];
#pragma unroll
        for (int ai = 0; ai < 2; ++ai)
#pragma unroll
            for (int m = 0; m < 4; ++m)
#pragma unroll
                for (int bj = 0; bj < 2; ++bj) gwv[ai][m][bj] = *(const u32x4*)(gate + (size_t)(row0 + ai * 128 + m * 16) * 3072 + BR * 1024 + col0 + bj * 128);
        __builtin_amdgcn_sched_barrier(0);
#pragma unroll
        for (int ai = 0; ai < 2; ++ai)
#pragma unroll
            for (int m = 0; m < 4; ++m) { const size_t row = row0 + ai * 128 + m * 16;
#pragma unroll
                for (int bj = 0; bj < 2; ++bj) { const int col = col0 + bj * 128;
                    const u32x4 gw = gwv[ai][m][bj];
                    float v[8];
                    v[0] = bflo(gw.x) * acc[ai][bj][m][0][0]; v[1] = bfhi(gw.x) * acc[ai][bj][m][0][1]; v[2] = bflo(gw.y) * acc[ai][bj][m][0][2]; v[3] = bfhi(gw.y) * acc[ai][bj][m][0][3];
                    v[4] = bflo(gw.z) * acc[ai][bj][m][1][0]; v[5] = bfhi(gw.z) * acc[ai][bj][m][1][1]; v[6] = bflo(gw.w) * acc[ai][bj][m][1][2]; v[7] = bfhi(gw.w) * acc[ai][bj][m][1][3];
                    bf16_t* mp = merged + row * 1024 + col;
                    if (BR > 0) { const u32x4 pm = *(const u32x4*)mp;
                        v[0] += bflo(pm.x); v[1] += bfhi(pm.x); v[2] += bflo(pm.y); v[3] += bfhi(pm.y); v[4] += bflo(pm.z); v[5] += bfhi(pm.z); v[6] += bflo(pm.w); v[7] += bfhi(pm.w); }
                    *(u32x4*)mp = pack8(v); } }
    }
};
struct EpiRes {
    static constexpr bool PERM = true, AFTER_DRAIN = false;
    float* xout; bf16_t* xb; float* ss; int next;
    __device__ __forceinline__ void operator()(const f32x4 (&acc)[2][2][4][2], const Unit& u, int wr, int wc, int fr, int fq) const {
        const int row0 = u.pm * 256 + wr * 64 + fr, col0 = u.pn * 256 + wc * 32 + 8 * fq;
        u32x4 xwv[2][4][2];
#pragma unroll
        for (int ai = 0; ai < 2; ++ai)
#pragma unroll
            for (int m = 0; m < 4; ++m)
#pragma unroll
                for (int bj = 0; bj < 2; ++bj) xwv[ai][m][bj] = *(const u32x4*)(xb + (size_t)(row0 + ai * 128 + m * 16) * 1024 + col0 + bj * 128);
        __builtin_amdgcn_sched_barrier(0);
#pragma unroll
        for (int ai = 0; ai < 2; ++ai)
#pragma unroll
            for (int m = 0; m < 4; ++m) { const size_t row = row0 + ai * 128 + m * 16; float part = 0.f;
#pragma unroll
                for (int bj = 0; bj < 2; ++bj) { const int col = col0 + bj * 128;
                    const u32x4 xw = xwv[ai][m][bj];
                    float v[8];
                    v[0] = bflo(xw.x) + acc[ai][bj][m][0][0]; v[1] = bfhi(xw.x) + acc[ai][bj][m][0][1]; v[2] = bflo(xw.y) + acc[ai][bj][m][0][2]; v[3] = bfhi(xw.y) + acc[ai][bj][m][0][3];
                    v[4] = bflo(xw.z) + acc[ai][bj][m][1][0]; v[5] = bfhi(xw.z) + acc[ai][bj][m][1][1]; v[6] = bflo(xw.w) + acc[ai][bj][m][1][2]; v[7] = bfhi(xw.w) + acc[ai][bj][m][1][3];
                    if (next) { *(u32x4*)(xb + row * 1024 + col) = pack8(v);
#pragma unroll
                        for (int e = 0; e < 8; ++e) part += v[e] * v[e]; }
                    else { *(f32x4*)(xout + row * 1024 + col) = (f32x4){v[0], v[1], v[2], v[3]}; *(f32x4*)(xout + row * 1024 + col + 4) = (f32x4){v[4], v[5], v[6], v[7]}; } }
                if (next) { part = quad_sum(part, fq * 16 + fr); if (fq == 0) ss[((size_t)u.pn * MC + row) * 4 + wc] = part; } }
    }
};
struct EpiGu {
    static constexpr bool PERM = true, AFTER_DRAIN = false;
    const float* ss2; bf16_t* hid; LAS float* rsb;
    __device__ __forceinline__ void operator()(const f32x4 (&acc)[2][2][4][2], const Unit& u, int wr, int wc, int fr, int fq) const {
        const int row0 = u.pm * 256 + wr * 64 + fr, col0 = u.pn * 128 + wc * 32 + 8 * fq;
        float rsv[2][4];
        unit_row_scales(rsv, ss2, rsb, u.pm, wr, wc, fr, fq);
#pragma unroll
        for (int ai = 0; ai < 2; ++ai)
#pragma unroll
            for (int m = 0; m < 4; ++m) { const size_t row = row0 + ai * 128 + m * 16;
                const float rs = rsv[ai][m]; float v[8];
#pragma unroll
                for (int e = 0; e < 8; ++e) { const float g = acc[ai][0][m][e >> 2][e & 3] * rs, uu = acc[ai][1][m][e >> 2][e & 3] * rs; v[e] = g * sigmoidf_(g) * uu; }
                *(u32x4*)(hid + row * DFF + col0) = pack8(v); }
    }
};

__device__ __forceinline__ int win_src(int n) {
    const int t = n >> 8, w = n & 255;
    if (t < 4) return n;
    if (t < 11) { const int hh = 4 * (t - 4) + ((w & 127) >> 5), d = (w >> 7) * 32;
        const int base = hh < 6 ? 1024 + hh * 64 : hh < 12 ? 1408 + (hh - 6) * 64 : hh < 20 ? 2176 + (hh - 12) * 64 : 2688 + (hh - 20) * 64; return base + d; }
    if (t < 15) { const int v = (t - 11) * 256 + w; return v < 384 ? 1792 + v : v < 896 ? 3200 + (v - 384) : -1; }
    return 3712 + (t - 15) * 256 + w;
}
__device__ __forceinline__ int wgu_src(int n) { const int t = n >> 8, w = n & 255; return w < 128 ? t * 128 + w : DFF + t * 128 + (w - 128); }
__device__ __forceinline__ void cvt_item(const float* W, int K, int N, bf16_t* WT, const float* rscale, int src0, int n0, int k0, LAS float* scr, int lane) {
    if (src0 < 0) {
        const int c = lane & 7;
#pragma unroll
        for (int j = 0; j < 4; ++j) { const int n = (lane >> 3) + 8 * j; *(u32x4*)(WT + (size_t)(n0 + n) * K + k0 + 8 * c) = (u32x4){0u, 0u, 0u, 0u}; }
        return;
    }
#pragma unroll 8
    for (int i = 0; i < 32; ++i) { const int kk = 2 * i + (lane >> 5); float v = W[(size_t)(k0 + kk) * N + src0 + (lane & 31)]; if (rscale) v *= rscale[k0 + kk]; scr[kk * 33 + (lane & 31)] = v; }
    asm volatile("s_waitcnt lgkmcnt(0)" ::: "memory");
    const int c = lane & 7;
#pragma unroll
    for (int j = 0; j < 4; ++j) { const int n = (lane >> 3) + 8 * j; const LAS float* s = scr + (8 * c) * 33 + n;
        u32x4 o; o.x = cvt_pk_bf16(s[0 * 33], s[1 * 33]); o.y = cvt_pk_bf16(s[2 * 33], s[3 * 33]); o.z = cvt_pk_bf16(s[4 * 33], s[5 * 33]); o.w = cvt_pk_bf16(s[6 * 33], s[7 * 33]);
        *(u32x4*)(WT + (size_t)(n0 + n) * K + k0 + 8 * c) = o; }
    asm volatile("s_waitcnt lgkmcnt(0)" ::: "memory");
}
__device__ __forceinline__ int rel_bucket(int rel) {
    const int n = rel < 0 ? -rel : rel; int b;
    if (n < 8) b = n; else b = 8 + (n >= 15) + (n >= 27) + (n >= 50) + (n >= 91) + (n >= 166) + (n >= 305) + (n >= 559);
    return b + (rel > 0 ? 16 : 0);
}
__device__ __forceinline__ void prep_chunk(const float* x, bf16_t* xb, float* ss1, int gw, int ngw, int lane) {
    for (int r0 = gw * 16; r0 < MC; r0 += ngw * 16) {
        float mine = 0.f;
        for (int k = 0; k < 16; ++k) { const int r = r0 + k;
            const f32x4* xr = (const f32x4*)(x + (size_t)r * 1024) + lane; float s = 0.f; f32x4 v[4];
#pragma unroll
            for (int j = 0; j < 4; ++j) { v[j] = xr[64 * j]; s += (v[j][0] * v[j][0] + v[j][1] * v[j][1]) + (v[j][2] * v[j][2] + v[j][3] * v[j][3]); }
            s = wave_sum(s, lane);
            u32x2* o = (u32x2*)(xb + (size_t)r * 1024) + lane;
#pragma unroll
            for (int j = 0; j < 4; ++j) o[64 * j] = (u32x2){cvt_pk_bf16(v[j][0], v[j][1]), cvt_pk_bf16(v[j][2], v[j][3])};
            if (lane == k) mine = s; }
        if (lane < 16) {
#pragma unroll
            for (int pn = 0; pn < 4; ++pn) *(f32x4*)(ss1 + ((size_t)pn * MC + r0 + lane) * 4) = (f32x4){pn == 0 ? mine : 0.f, 0.f, 0.f, 0.f}; }
    }
}
__device__ __forceinline__ void prologue(const Args& a, unsigned char* ws, LAS unsigned char* lds, int gw, int ngw, int wave, int lane) {
    LAS float* scr = (LAS float*)(lds + wave * 8448);
    constexpr int I0 = 3456, I1 = I0 + 256, I2 = I1 + 192, I3 = I2 + 256, I4 = I3 + 512, I5 = I4 + 2816, I6 = I5 + 1408;
    for (int it = gw; it < DEPTH * I6; it += ngw) {
        const int l = it / I6; int r = it % I6; unsigned char* wl = ws + WS_W + (size_t)l * WL;
        if (r < I0) { const int kb = r / 216, nb = r % 216; cvt_item(a.in[I_WIN] + (size_t)l * 1024 * INC, 1024, INC, (bf16_t*)(wl + W_IN), a.in[I_N1G] + l * 1024, win_src(nb * 32), nb * 32, kb * 64, scr, lane); continue; }
        if (r < I1) { r -= I0; const int kb = r / 32, nb = r % 32; cvt_item(a.in[I_WPA] + (size_t)l * 512 * 1024, 512, 1024, (bf16_t*)(wl + W_PA), nullptr, nb * 32, nb * 32, kb * 64, scr, lane); continue; }
        if (r < I2) { r -= I1; const int kb = r / 32, nb = r % 32; cvt_item(a.in[I_WPB] + (size_t)l * 384 * 1024, 384, 1024, (bf16_t*)(wl + W_PB), nullptr, nb * 32, nb * 32, kb * 64, scr, lane); continue; }
        if (r < I3) { r -= I2; const int kb = r / 32, nb = r % 32; cvt_item(a.in[I_WPC] + (size_t)l * 512 * 1024, 512, 1024, (bf16_t*)(wl + W_PC), nullptr, nb * 32, nb * 32, kb * 64, scr, lane); continue; }
        if (r < I4) { r -= I3; const int kb = r / 32, nb = r % 32; cvt_item(a.in[I_WO] + (size_t)l * 1024 * 1024, 1024, 1024, (bf16_t*)(wl + W_O), nullptr, nb * 32, nb * 32, kb * 64, scr, lane); continue; }
        if (r < I5) { r -= I4; const int kb = r / 176, nb = r % 176; cvt_item(a.in[I_WGU] + (size_t)l * 1024 * 2 * DFF, 1024, 2 * DFF, (bf16_t*)(wl + W_GU), a.in[I_N2G] + l * 1024, wgu_src(nb * 32), nb * 32, kb * 64, scr, lane); continue; }
        { r -= I5; const int kb = r / 32, nb = r % 32; cvt_item(a.in[I_WDN] + (size_t)l * DFF * 1024, DFF, 1024, (bf16_t*)(wl + W_DN), nullptr, nb * 32, nb * 32, kb * 64, scr, lane); }
    }
    for (int i = gw * 64 + lane; i < DEPTH * 8 * 128 * 128 / 8; i += ngw * 64) {
        const int l = i / (8 * 128 * 128 / 8), r = i % (8 * 128 * 128 / 8);
        const f32x4 p = *(const f32x4*)(a.in[I_SGUW] + (size_t)i * 8), q = *(const f32x4*)(a.in[I_SGUW] + (size_t)i * 8 + 4);
        *(u32x4*)((bf16_t*)(ws + WS_W + (size_t)l * WL + W_SGU) + (size_t)r * 8) = (u32x4){cvt_pk_bf16(p[0], p[1]), cvt_pk_bf16(p[2], p[3]), cvt_pk_bf16(q[0], q[1]), cvt_pk_bf16(q[2], q[3])};
    }
    float* lut = (float*)(ws + WS_LUT);
    for (int i = gw * 64 + lane; i < 10 * LUTN; i += ngw * 64) { const int h = i / LUTN, rel = (i % LUTN) - LUTOFF; lut[i] = a.in[I_RELB][rel_bucket(rel) * 10 + h] * LOG2E; }
    float* pt = (float*)(ws + WS_PT);
    for (int i = gw * 64 + lane; i < DEPTH * 2176; i += ngw * 64) { const int l = i / 2176, r = i % 2176;
        pt[l * PT_L + r] = r < 128 ? a.in[I_SUBG][l * 128 + r] : r < 640 ? a.in[I_LNG][l * 512 + r - 128] : r < 1152 ? a.in[I_LNB][l * 512 + r - 640] : a.in[I_SGUB][l * 1024 + r - 1152]; }
    if (gw < DEPTH) { const int l = gw;
        const float s1 = wave_sum(a.in[I_LQ1][l * 64 + lane] * a.in[I_LK1][l * 64 + lane], lane), s2 = wave_sum(a.in[I_LQ2][l * 64 + lane] * a.in[I_LK2][l * 64 + lane], lane);
        const float lam_init = 0.8f - 0.6f * expf(-0.3f * (float)l);
        if (lane == 0) { pt[l * PT_L + PT_LAM] = expf(s1) - expf(s2) + lam_init; pt[l * PT_L + PT_LAM + 1] = lam_init; } }
    float* gt = (float*)(ws + WS_GT);
    for (int i = gw * 64 + lane; i < DEPTH * NQKH * 64; i += ngw * 64) { const int l = i / (NQKH * 64), hh = (i / 64) % NQKH, d = i % 64;
        const float* gp = hh < 6 ? a.in[I_QNB] : hh < 12 ? a.in[I_KNB] : hh < 20 ? a.in[I_QNC] : a.in[I_KNC];
        gt[i] = gp[l * 64 + d] * ((hh < 6 || (hh >= 12 && hh < 20)) ? 0.125f * LOG2E : 1.f); }
    prep_chunk(a.in[I_XP], (bf16_t*)(ws + WS_XB), (float*)(ws + WS_SS1), gw, ngw, lane);
}

constexpr int DA_KB = 16384, DA_STG = 32768;
__device__ __forceinline__ void diffattn_item(unsigned char* ws, LAS unsigned char* lds, int l, int lgS, int b, int h, int qb, int tid, int wave, int lane, bool load_lut) {
    const int S = 1 << lgS, T = S >> 6;
    LAS float* lut = (LAS float*)lds;
    LAS unsigned char* stg = lds + 32768;
    const int ql = lane & 15, quad = lane >> 4, q0 = qb * 128 + wave * 16;
    const bf16_t* qkb = (const bf16_t*)(ws + WS_QK) + ((size_t)b << lgS) * QKP;
    const bf16_t* kg[2]; const bf16_t* vg[2];
#pragma unroll
    for (int i = 0; i < 2; ++i) { const int P = (i * 8 + wave) * 64 + lane, key = P >> 4, seg = (P & 15) ^ (key & 15), e = P >> 3, part = (P & 7) ^ ((e >> 1) & 7);
        kg[i] = qkb + (size_t)key * QKP + (20 + (seg >> 3) * 4 + h) * 64 + (seg & 7) * 8;
        vg[i] = (const bf16_t*)(ws + WS_VTC) + ((size_t)(b * 512 + h * 128 + e) << lgS) + part * 8; }
#define DA_DMA(tt, sidx) do { _Pragma("unroll") for (int i = 0; i < 2; ++i) { \
        __builtin_amdgcn_global_load_lds((const unsigned*)(kg[i] + (size_t)(tt) * 64 * QKP), (LAS unsigned*)(stg + (sidx) * DA_STG + (i * 8 + wave) * 1024), 16, 0, 0); \
        __builtin_amdgcn_global_load_lds((const unsigned*)(vg[i] + (tt) * 64), (LAS unsigned*)(stg + (sidx) * DA_STG + DA_KB + (i * 8 + wave) * 1024), 16, 0, 0); } } while (0)
    DA_DMA(0, 0); DA_DMA(1, 1);
    if (load_lut) { const float* glut = (const float*)(ws + WS_LUT) + (6 + h) * LUTN;
      for (int i = tid; i < LUTN; i += 512) lut[i] = glut[i]; }
    bf16x8 qf[2][2];
#pragma unroll
    for (int c = 0; c < 2; ++c)
#pragma unroll
        for (int ks = 0; ks < 2; ++ks) qf[c][ks] = *(const bf16x8*)(qkb + (size_t)(q0 + ql) * QKP + (12 + c * 4 + h) * 64 + 32 * ks + 8 * quad);
    f32x4 o[2][8];
#pragma unroll
    for (int c = 0; c < 2; ++c)
#pragma unroll
        for (int dt = 0; dt < 8; ++dt) o[c][dt] = (f32x4){0.f, 0.f, 0.f, 0.f};
    float lsum0 = 0.f, lsum1 = 0.f;
    const LAS float* lutq = lut + LUTOFF - (q0 + ql) + 4 * quad;
    int kfo[2][2], vfo[2][2];
#pragma unroll
    for (int c = 0; c < 2; ++c)
#pragma unroll
        for (int ks = 0; ks < 2; ++ks) kfo[c][ks] = ql * 256 + (((c * 8 + ks * 4 + quad) ^ ql) << 4);
#pragma unroll
    for (int hf = 0; hf < 2; ++hf)
#pragma unroll
        for (int x = 0; x < 2; ++x) vfo[hf][x] = DA_KB + ql * 128 + (((4 * hf + (quad >> 1) + 2 * x) ^ ((ql >> 1) & 7)) << 4) + 8 * (quad & 1);
    asm volatile("s_waitcnt vmcnt(4) lgkmcnt(0)" ::: "memory"); __builtin_amdgcn_s_barrier(); asm volatile("" ::: "memory");
#define DA_LDK(sbp, hf_) do { _Pragma("unroll") for (int kt = 0; kt < 2; ++kt) _Pragma("unroll") for (int c = 0; c < 2; ++c) _Pragma("unroll") for (int ks = 0; ks < 2; ++ks) \
        kf[kt][c][ks] = *(const LAS bf16x8*)((sbp) + (32 * (hf_) + 16 * kt) * 256 + kfo[c][ks]); } while (0)
#define DA_LDB(k0_) do { _Pragma("unroll") for (int kt = 0; kt < 2; ++kt) _Pragma("unroll") for (int j = 0; j < 4; ++j) biasv[kt][j] = lutq[(k0_) + 16 * kt + j]; } while (0)
    bf16x8 kf[2][2][2]; f32x4 biasv[2];
    DA_LDK(stg, 0); DA_LDB(0);
    int s0 = 0;
    for (int t = 0; t < T; ++t) {
        const int s1 = s0 == 2 ? 0 : s0 + 1, s2 = s1 == 2 ? 0 : s1 + 1;
        if (t + 2 < T) DA_DMA(t + 2, s2);
        const LAS unsigned char* sb = stg + s0 * DA_STG;
#pragma unroll
        for (int hf = 0; hf < 2; ++hf) {
            f32x4 st[2][2];
#pragma unroll
            for (int kt = 0; kt < 2; ++kt)
#pragma unroll
                for (int c = 0; c < 2; ++c) { f32x4 z = MFMA16(kf[kt][c][0], qf[c][0], biasv[kt]); st[c][kt] = MFMA16(kf[kt][c][1], qf[c][1], z); }
            __builtin_amdgcn_sched_barrier(0);
            s16x4 v0[4], v1[4], w0[4], w1[4];
#pragma unroll
            for (int dt = 0; dt < 4; ++dt) { v0[dt] = *(const LAS s16x4*)(sb + dt * 2048 + vfo[hf][0]); v1[dt] = *(const LAS s16x4*)(sb + dt * 2048 + vfo[hf][1]); }
            if (hf == 0) DA_LDK(sb, 1);
            __builtin_amdgcn_sched_barrier(0);
#pragma unroll
            for (int kt = 0; kt < 2; ++kt)
#pragma unroll
                for (int j = 0; j < 4; ++j) { const float p0 = fexp2(st[0][kt][j]), p1 = fexp2(st[1][kt][j]); lsum0 += p0; lsum1 += p1; st[0][kt][j] = p0; st[1][kt][j] = p1; }
            bf16x8 pf[2];
#pragma unroll
            for (int c = 0; c < 2; ++c) { u32x4 w; w.x = cvt_pk_bf16(st[c][0][0], st[c][0][1]); w.y = cvt_pk_bf16(st[c][0][2], st[c][0][3]); w.z = cvt_pk_bf16(st[c][1][0], st[c][1][1]); w.w = cvt_pk_bf16(st[c][1][2], st[c][1][3]);
                pf[c] = __builtin_bit_cast(bf16x8, w); }
            __builtin_amdgcn_sched_barrier(0);
#pragma unroll
            for (int dt = 0; dt < 4; ++dt) { w0[dt] = *(const LAS s16x4*)(sb + (dt + 4) * 2048 + vfo[hf][0]); w1[dt] = *(const LAS s16x4*)(sb + (dt + 4) * 2048 + vfo[hf][1]); }
            if (hf == 0) DA_LDB(t * 64 + 32);
#pragma unroll
            for (int dt = 0; dt < 4; ++dt) { const bf16x8 vf = __builtin_shufflevector(v0[dt], v1[dt], 0, 1, 2, 3, 4, 5, 6, 7);
                o[0][dt] = MFMA16(vf, pf[0], o[0][dt]); o[1][dt] = MFMA16(vf, pf[1], o[1][dt]); }
            __builtin_amdgcn_sched_barrier(0);
#pragma unroll
            for (int dt = 0; dt < 4; ++dt) { const bf16x8 vf = __builtin_shufflevector(w0[dt], w1[dt], 0, 1, 2, 3, 4, 5, 6, 7);
                o[0][dt + 4] = MFMA16(vf, pf[0], o[0][dt + 4]); o[1][dt + 4] = MFMA16(vf, pf[1], o[1][dt + 4]); }
            __builtin_amdgcn_sched_barrier(0);
        }
        if (t + 2 < T) asm volatile("s_waitcnt vmcnt(4) lgkmcnt(0)" ::: "memory"); else asm volatile("s_waitcnt vmcnt(0) lgkmcnt(0)" ::: "memory");
        __builtin_amdgcn_s_barrier(); asm volatile("" ::: "memory");
        __builtin_amdgcn_sched_barrier(0);
        if (t + 1 < T) { DA_LDK(stg + s1 * DA_STG, 0); DA_LDB((t + 1) * 64); }
        s0 = s1;
    }
#undef DA_LDB
#undef DA_LDK
#undef DA_DMA
    lsum0 = quad_sum(lsum0, lane); lsum1 = quad_sum(lsum1, lane);
    const float* pt = (const float*)(ws + WS_PT) + l * PT_L;
    const float lam = pt[PT_LAM], lam_init = pt[PT_LAM + 1];
    const float i1 = 1.f / lsum0, i2 = lam / lsum1; float ssq = 0.f;
#pragma unroll
    for (int dt = 0; dt < 8; ++dt)
#pragma unroll
        for (int j = 0; j < 4; ++j) { const float v = o[0][dt][j] * i1 - o[1][dt][j] * i2; o[0][dt][j] = v; ssq += v * v; }
    ssq = quad_sum(ssq, lane);
    const float r = rsqrtf(ssq * (1.f / 128.f) + 1e-6f) * (1.f - lam_init);
    bf16_t* outp = (bf16_t*)(ws + WS_COUT) + ((size_t)(b << lgS) + q0 + ql) * 512 + h * 128 + 4 * quad;
    const float* sg = pt + PT_SUBG + 4 * quad;
#pragma unroll
    for (int dt = 0; dt < 8; ++dt) { const f32x4 g = *(const f32x4*)(sg + 16 * dt);
        *(u32x2*)(outp + 16 * dt) = (u32x2){cvt_pk_bf16(o[0][dt][0] * r * g[0], o[0][dt][1] * r * g[1]), cvt_pk_bf16(o[0][dt][2] * r * g[2], o[0][dt][3] * r * g[3])}; }
}

__device__ __forceinline__ void dilattn_item(unsigned char* ws, LAS unsigned char* lds, int lgS, int b, int sp, int j, int tid, int wave, int lane) {
    const int S = 1 << lgS;
    const int ql = lane & 15, quad = lane >> 4;
    const bf16_t* qkb = (const bf16_t*)(ws + WS_QK) + ((size_t)b << lgS) * QKP;
    bf16_t* bout = (bf16_t*)(ws + WS_BOUT) + ((size_t)b << lgS) * 384;
    float* lb = (float*)(ws + WS_LB) + ((size_t)j * MC + ((size_t)b << lgS)) * 4;
    const float* glut = (const float*)(ws + WS_LUT);
    LAS float* lutl = (LAS float*)lds;
#pragma unroll
    for (int i0 = 0; i0 < 3 * 4096; i0 += 512) { const int i = i0 + tid; lutl[i] = glut[(2 * (i >> 12) + j) * LUTN + LUTOFF - 2048 + (i & 4095)]; }
    __syncthreads();
    for (int uu = wave; uu < 48; uu += 8) {
        const int gi = uu >> 4, u = uu & 15, lg = 2 * gi, dil = 1 << lg, r = u & (dil - 1), n0 = (sp << (8 - lg)) + 16 * (u >> lg), L = S >> lg, hh = 2 * gi + j;
        const int tokq = ((n0 + ql) << lg) + r;
        bf16x8 qf[2];
#pragma unroll
        for (int ks = 0; ks < 2; ++ks) qf[ks] = *(const bf16x8*)(qkb + (size_t)(((((n0 >> 4) << lg) + r) << 4) + ql) * QKP + hh * 64 + 32 * ks + 8 * quad);
        f32x4 st[10];
#pragma unroll
        for (int kt = 0; kt < 10; ++kt) { int n = n0 - 64 + 32 * (kt >> 1) + 8 * (ql >> 2) + 4 * (kt & 1) + (ql & 3); n = n < 0 ? 0 : (n > L - 1 ? L - 1 : n);
            const bf16_t* kp = qkb + (size_t)(((((n >> 4) << lg) + r) << 4) + (n & 15)) * QKP + (6 + hh) * 64 + 8 * quad;
            const bf16x8 ka0 = *(const bf16x8*)kp, ka1 = *(const bf16x8*)(kp + 32);
            f32x4 z = (f32x4){0.f, 0.f, 0.f, 0.f}; z = MFMA16(ka0, qf[0], z); st[kt] = MFMA16(ka1, qf[1], z); }
        float lsum = 0.f;
        const LAS float* lutp = lutl + gi * 4096 + 2048;
#pragma unroll
        for (int kt = 0; kt < 10; ++kt)
#pragma unroll
            for (int e = 0; e < 4; ++e) { const int n = n0 - 64 + 32 * (kt >> 1) + 8 * quad + 4 * (kt & 1) + e, rel = n - (n0 + ql);
                const bool valid = (n >= 0) && (n < L) && (rel <= 64) && (rel >= -64);
                const float bias = lutp[rel * dil];
                const float p = valid ? fexp2(st[kt][e] + bias) : 0.f; lsum += p; st[kt][e] = p; }
        f32x4 o[4];
#pragma unroll
        for (int dt = 0; dt < 4; ++dt) o[dt] = (f32x4){0.f, 0.f, 0.f, 0.f};
        const bf16_t* vb = (const bf16_t*)(ws + WS_VTB) + ((size_t)(b * 384 + hh * 64 + ql) << lgS);
#pragma unroll
        for (int i = 0; i < 5; ++i) {
            u32x4 w; w.x = cvt_pk_bf16(st[2 * i][0], st[2 * i][1]); w.y = cvt_pk_bf16(st[2 * i][2], st[2 * i][3]); w.z = cvt_pk_bf16(st[2 * i + 1][0], st[2 * i + 1][1]); w.w = cvt_pk_bf16(st[2 * i + 1][2], st[2 * i + 1][3]);
            const bf16x8 pf = __builtin_bit_cast(bf16x8, w);
            int na = n0 - 64 + 32 * i + 8 * quad;
            na = na < 0 ? 0 : (na > L - 8 ? L - 8 : na);
#pragma unroll
            for (int dt = 0; dt < 4; ++dt) { const bf16_t* vp = vb + ((size_t)(dt * 16) << lgS);
                const bf16x8 vf = *(const bf16x8*)(vp + (((((na >> 4) << lg) + r) << 4) + (na & 15)));
                o[dt] = MFMA16(vf, pf, o[dt]); }
        }
        lsum = quad_sum(lsum, lane);
        bf16_t* op = bout + (size_t)tokq * 384 + hh * 64 + 4 * quad;
#pragma unroll
        for (int dt = 0; dt < 4; ++dt) *(u32x2*)(op + 16 * dt) = (u32x2){cvt_pk_bf16(o[dt][0], o[dt][1]), cvt_pk_bf16(o[dt][2], o[dt][3])};
        if (quad == 0) lb[(size_t)tokq * 4 + gi] = lsum;
    }
    asm volatile("s_waitcnt vmcnt(0)" ::: "memory"); __builtin_amdgcn_fence(__ATOMIC_SEQ_CST, "workgroup"); __syncthreads(); __builtin_amdgcn_fence(__ATOMIC_SEQ_CST, "workgroup");
    for (int idx = tid; idx < 256 * 24; idx += 512) {
        const int tok = sp * 256 + idx / 24, rem = idx % 24, gi = rem >> 3, piece = rem & 7, hh = 2 * gi + j;
        const f32x4 lp = *(const f32x4*)(lb + (size_t)tok * 4);
        const float inv = 1.f / (lp[0] + lp[1] + lp[2]);
        u32x4* p = (u32x4*)(bout + (size_t)tok * 384 + hh * 64 + piece * 8); const u32x4 w = *p;
        u32x4 o; o.x = cvt_pk_bf16(bflo(w.x) * inv, bfhi(w.x) * inv); o.y = cvt_pk_bf16(bflo(w.y) * inv, bfhi(w.y) * inv); o.z = cvt_pk_bf16(bflo(w.z) * inv, bfhi(w.z) * inv); o.w = cvt_pk_bf16(bflo(w.w) * inv, bfhi(w.w) * inv);
        *p = o;
    }
    __syncthreads();
}

__device__ __forceinline__ void sgu_item(unsigned char* ws, LAS unsigned char* lds, int l, int ci, int tid, int wave, int lane) {
    const float* ptab = (const float*)(ws + WS_PT) + l * PT_L;
    typedef float f32x2 __attribute__((ext_vector_type(2)));
    LAS f32x2* stats = (LAS f32x2*)lds;
    LAS unsigned char* img = lds + 1024 + wave * 17408;
    const bf16_t* zv = (const bf16_t*)(ws + WS_ZV) + (size_t)ci * 128 * 512;
    const bf16_t* zu = (const bf16_t*)(ws + WS_ZU) + (size_t)ci * 128 * 512;
    bf16_t* aout = (bf16_t*)(ws + WS_AOUT) + (size_t)ci * 128 * 512;
#pragma unroll
    for (int t = 0; t < 16; ++t) { const int tok = wave * 16 + t;
        const u32x4 w = *(const u32x4*)(zv + (size_t)tok * 512 + lane * 8);
        float v[8] = {bflo(w.x), bfhi(w.x), bflo(w.y), bfhi(w.y), bflo(w.z), bfhi(w.z), bflo(w.w), bfhi(w.w)};
        float s = 0.f;
#pragma unroll
        for (int e = 0; e < 8; ++e) s += v[e];
        const float mean = wave_sum(s, lane) * (1.f / 512.f); float s2 = 0.f;
#pragma unroll
        for (int e = 0; e < 8; ++e) { const float d = v[e] - mean; s2 += d * d; }
        const float rstd = rsqrtf(wave_sum(s2, lane) * (1.f / 512.f) + 1e-5f);
        if (lane == 0) stats[tok] = (f32x2){mean, rstd}; }
    __syncthreads();
    const int g = wave;
    { const int tl = lane >> 3, cp = lane & 7; float gam[8], bet[8];
#pragma unroll
      for (int e = 0; e < 8; ++e) { gam[e] = ptab[PT_LNG + g * 64 + 8 * cp + e]; bet[e] = ptab[PT_LNB + g * 64 + 8 * cp + e]; }
#pragma unroll
      for (int it = 0; it < 16; ++it) { const int tok = 8 * it + tl; const f32x2 ms = stats[tok];
          const u32x4 w = *(const u32x4*)(zv + (size_t)tok * 512 + g * 64 + 8 * cp);
          float v[8] = {bflo(w.x), bfhi(w.x), bflo(w.y), bfhi(w.y), bflo(w.z), bfhi(w.z), bflo(w.w), bfhi(w.w)};
#pragma unroll
          for (int e = 0; e < 8; ++e) v[e] = (v[e] - ms[0]) * ms[1] * gam[e] + bet[e];
          LAS u32x2* d = (LAS u32x2*)(img + tok * 136 + cp * 16);
          d[0] = (u32x2){cvt_pk_bf16(v[0], v[1]), cvt_pk_bf16(v[2], v[3])}; d[1] = (u32x2){cvt_pk_bf16(v[4], v[5]), cvt_pk_bf16(v[6], v[7])}; } }
    __syncthreads();
    const int ql = lane & 15, quad = lane >> 4;
    typedef short v4i16_t __attribute__((ext_vector_type(4)));
    bf16x8 af[4][4];
#pragma unroll
    for (int dt = 0; dt < 4; ++dt)
#pragma unroll
        for (int ks = 0; ks < 4; ++ks) {
            const LAS unsigned char* p0 = img + (32 * ks + 8 * quad + (ql >> 2)) * 136 + 32 * dt + 8 * (ql & 3);
            const s16x4 t0 = __builtin_bit_cast(s16x4, __builtin_amdgcn_ds_read_tr16_b64_v4i16((LAS v4i16_t*)p0));
            const s16x4 t1 = __builtin_bit_cast(s16x4, __builtin_amdgcn_ds_read_tr16_b64_v4i16((LAS v4i16_t*)(p0 + 4 * 136)));
            af[dt][ks] = __builtin_shufflevector(t0, t1, 0, 1, 2, 3, 4, 5, 6, 7); }
    const bf16_t* wg = (const bf16_t*)(ws + WS_W + (size_t)l * WL + W_SGU) + (size_t)g * 128 * 128;
#pragma unroll 2
    for (int pt = 0; pt < 8; ++pt) {
        f32x4 acc[4];
#pragma unroll
        for (int dt = 0; dt < 4; ++dt) acc[dt] = (f32x4){0.f, 0.f, 0.f, 0.f};
#pragma unroll
        for (int ks = 0; ks < 4; ++ks) { const bf16x8 bfr = *(const bf16x8*)(wg + (size_t)(16 * pt + ql) * 128 + 32 * ks + 8 * quad);
#pragma unroll
            for (int dt = 0; dt < 4; ++dt) acc[dt] = MFMA16(af[dt][ks], bfr, acc[dt]); }
        const int tok = 16 * pt + ql; const float bias = ptab[PT_SGUB + g * 128 + tok];
#pragma unroll
        for (int dt = 0; dt < 4; ++dt) { const int col = g * 64 + 16 * dt + 4 * quad;
            const u32x2 uw = *(const u32x2*)(zu + (size_t)tok * 512 + col);
            *(u32x2*)(aout + (size_t)tok * 512 + col) = (u32x2){cvt_pk_bf16(bflo(uw.x) * (acc[dt][0] + bias), bfhi(uw.x) * (acc[dt][1] + bias)), cvt_pk_bf16(bflo(uw.y) * (acc[dt][2] + bias), bfhi(uw.y) * (acc[dt][3] + bias))}; }
    }
    __syncthreads();
}

#ifndef PHM
#define PHM 127
#endif
#ifndef IM
#define IM 7
#endif
#define GRID_SYNC() do { asm volatile("s_waitcnt vmcnt(0)" ::: "memory"); __syncthreads(); \
    grid.sync(); \
    if (threadIdx.x < 64) { __builtin_amdgcn_fence(__ATOMIC_ACQUIRE, "agent"); asm volatile("s_waitcnt vmcnt(0)" ::: "memory"); } __syncthreads(); } while (0)
__global__ void __launch_bounds__(512, 2) fwd(Args a) {
    extern __shared__ __attribute__((aligned(16))) unsigned char lds_raw[];
    LAS unsigned char* lds = (LAS unsigned char*)lds_raw;
    cg::grid_group grid = cg::this_grid();
    int s = a.lo;
    if (s == 0) {
        unsigned char* ws = a.ws; int tid = threadIdx.x, bx = blockIdx.x, G = gridDim.x;
        const int lane = tid & 63, wave = __builtin_amdgcn_readfirstlane(tid >> 6), gw = bx * 8 + wave, ngw = G * 8;
        if (PHM & 1) prologue(a, ws, lds, gw, ngw, wave, lane);
        ++s; if (s < a.hi) GRID_SYNC();
    }
#ifdef PROBE_P
    int probe_rep = 0;
#ifdef PROBE_IM
#define PROBE_SEL(x) (!probe_rep || (PROBE_IM & (x)))
#else
#define PROBE_SEL(x) true
#endif
#else
#define PROBE_SEL(x) true
#endif
    for (; s < a.hi; ++s) {
        size_t zo = 0; int bx = blockIdx.x, G = gridDim.x;
        asm volatile("" : "+s"(zo), "+s"(bx), "+s"(G));
        unsigned char* ws = a.ws + zo;
        const int t = s - 1, c = t / 24, l = (t % 24) / 6, p = t % 6;
        const int lgS = c < 2 ? 11 : 12;
        unsigned char* wl = ws + WS_W + (size_t)l * WL;
        const size_t xbo = (c & 1) ? WS_XB2 : WS_XB, xbn = (c & 1) ? WS_XB : WS_XB2;
        if (p == 0 && (PHM & 2)) {
            pg8::Gemm g{(const bf16_t*)(ws + xbo), (const bf16_t*)(wl + W_IN), MC, ZN, 1024}; pg8::StaticOrder S; S.init(MC, ZN, G, bx);
            EpiWin E{ws, l, lgS, (LAS float*)(lds + 131072)};
            pg8::gemm_phase<EpiWin, pg8::StaticOrder, true, true>(lds, g, S, E);
        } else if (p == 1 && (PHM & 4)) {
            int tid = threadIdx.x; asm volatile("" : "+v"(tid));
            const int lane = tid & 63, wave = __builtin_amdgcn_readfirstlane(tid >> 6);
            const int nqb = (1 << lgS) / 128, NC = (MC / 128) * 4, NB = (MC / 256) * 2, NA = MC / 128;
            {
            const int vbx = (G & 7) == 0 ? (bx & 7) * (G >> 3) + (bx >> 3) : bx;
            if ((IM & 1) && PROBE_SEL(1)) { int lut_h = -1; for (int it = vbx; it < NC; it += G) { const int qb = it % nqb, bh = it / nqb; diffattn_item(ws, lds, l, lgS, bh >> 2, bh & 3, qb, tid, wave, lane, (bh & 3) != lut_h); lut_h = bh & 3; } }
            if ((IM & 2) && PROBE_SEL(2)) for (int it = bx; it < NB; it += G) { const int j = it & 1, gsp = it >> 1, nsp = (1 << lgS) / 256; dilattn_item(ws, lds, lgS, gsp / nsp, gsp % nsp, j, tid, wave, lane); }
            if ((IM & 4) && PROBE_SEL(4)) for (int it = bx; it < NA; it += G) sgu_item(ws, lds, l, it, tid, wave, lane);
            }
        } else if (p == 2 && (PHM & 8)) {
            pg8::StaticOrder S; S.init(MC, 1024, G, bx);
#pragma nounroll
            for (int br = 0; br < 3; ++br) {
                const size_t aoff = br == 0 ? WS_AOUT : br == 1 ? WS_BOUT : WS_COUT, woff = br == 0 ? W_PA : br == 1 ? W_PB : W_PC;
                pg8::Gemm g{(const bf16_t*)(ws + aoff), (const bf16_t*)(wl + woff), MC, 1024, br == 1 ? 384 : 512}; EpiWp E{ws, br};
                pg8::gemm_phase<EpiWp, pg8::StaticOrder, true, true>(lds, g, S, E);
            }
        } else if ((p == 3 && (PHM & 16)) || (p == 5 && (PHM & 64))) {
            float* xout = a.out + (size_t)c * MC * 1024 + zo;
            const bool wo = p == 3;
            pg8::Gemm g{(const bf16_t*)(ws + (wo ? WS_MERGED : WS_HID)), (const bf16_t*)(wl + (wo ? W_O : W_DN)), MC, 1024, wo ? 1024 : DFF}; pg8::StaticOrder S; S.init(MC, 1024, G, bx);
            EpiRes E{xout, (bf16_t*)(ws + xbo), (float*)(ws + (wo ? WS_SS2 : WS_SS1)), (wo || l < DEPTH - 1) ? 1 : 0};
            pg8::gemm_phase<EpiRes, pg8::StaticOrder, true, true>(lds, g, S, E);
            if (!wo && l == DEPTH - 1 && c + 1 < NCHUNK) {
                int tid = threadIdx.x; asm volatile("" : "+v"(tid));
                const int lane = tid & 63, wave = __builtin_amdgcn_readfirstlane(tid >> 6);
                const float* xn = ((c + 1) < 2 ? a.in[I_XP] + (size_t)(c + 1) * MC * 1024 : a.in[I_XS]) + zo;
                prep_chunk(xn, (bf16_t*)(ws + xbn), (float*)(ws + WS_SS1), bx * 8 + wave, G * 8, lane);
            }
        } else if (p == 4 && (PHM & 32)) {
            pg8::Gemm g{(const bf16_t*)(ws + xbo), (const bf16_t*)(wl + W_GU), MC, 2 * DFF, 1024}; pg8::StaticOrder S; S.init(MC, 2 * DFF, G, bx);
            EpiGu E{(const float*)(ws + WS_SS2), (bf16_t*)(ws + WS_HID), (LAS float*)(lds + 131072)};
            pg8::gemm_phase<EpiGu, pg8::StaticOrder, true, true>(lds, g, S, E);
        }
        if (s + 1 < a.hi) GRID_SYNC();
#ifdef PROBE_P
        if (p == PROBE_P && !probe_rep) { probe_rep = 1; --s; } else probe_rep = 0;
#endif
    }
}

#ifndef MK_MULTI
#define MK_MULTI 0
#endif
extern "C" void kernel_launch(void* const* d_in, const int* in_sizes, int n_in, void* d_out, int out_size, void* d_ws, size_t ws_size, hipStream_t stream) {
    static int grid = 0;
    if (grid == 0) {
        if (n_in != 25 || ws_size < WS_END) { fprintf(stderr, "kernel_launch: need 25 inputs and %zu bytes of workspace (got %d, %zu)\n", (size_t)WS_END, n_in, ws_size); grid = -1; return; }
        int dev = 0, cus = 0, per_cu = 0;
        if (hipGetDevice(&dev) != hipSuccess || hipDeviceGetAttribute(&cus, hipDeviceAttributeMultiprocessorCount, dev) != hipSuccess) { grid = -1; return; }
        if (hipFuncSetAttribute((const void*)fwd, hipFuncAttributeMaxDynamicSharedMemorySize, LDS_BYTES) != hipSuccess) { fprintf(stderr, "kernel_launch: hipFuncSetAttribute failed\n"); grid = -1; return; }
        if (hipOccupancyMaxActiveBlocksPerMultiprocessor(&per_cu, (const void*)fwd, 512, LDS_BYTES) != hipSuccess || per_cu < 1) per_cu = 1;
        (void)hipGetLastError();
        grid = cus * per_cu;
        fprintf(stderr, "kernel_launch: grid %d (%d CUs x %d), ws %zu\n", grid, cus, per_cu, ws_size);
    }
    if (grid < 0) return;
    Args a{};
    for (int i = 0; i < 25; ++i) a.in[i] = (const float*)d_in[i];
    a.out = (float*)d_out; a.ws = (unsigned char*)d_ws;
#if MK_MULTI
    for (int s = 0; s < NSTEPS; ++s) { a.lo = s; a.hi = s + 1; void* args[] = {&a};
        hipError_t e = hipLaunchCooperativeKernel((const void*)fwd, dim3(grid), dim3(512), args, LDS_BYTES, stream);
        if (e != hipSuccess) { fprintf(stderr, "kernel_launch: launch %d failed: %s\n", s, hipGetErrorString(e)); break; } }
#else
    a.lo = 0; a.hi = NSTEPS; void* args[] = {&a};
    hipError_t e = hipLaunchCooperativeKernel((const void*)fwd, dim3(grid), dim3(512), args, LDS_BYTES, stream);
    if (e != hipSuccess) fprintf(stderr, "kernel_launch: cooperative launch failed: %s (grid %d)\n", hipGetErrorString(e), grid);
#endif
}
```

```cpp
#include <hip/hip_runtime.h>
#include <hip/hip_cooperative_groups.h>
#include <cstdio>
#include <cstdint>
namespace cg = cooperative_groups;
namespace pg8 {
#define PG8_LAS __attribute__((address_space(3)))
typedef unsigned short bf16_t;
typedef short bf16x8 __attribute__((ext_vector_type(8)));
typedef float f32x4 __attribute__((ext_vector_type(4)));
typedef unsigned u32x4 __attribute__((ext_vector_type(4)));
constexpr int BM = 256, BK = 64, HALF = 128, HTB = HALF * BK * 2  , STAGE_BYTES = 8 * HTB, NXCD = 8, WGM = 8;

__host__ __device__ __forceinline__ int lds_byte(int r, int c) { const int st = (r >> 4) * 2 + (c >> 5), rr = r & 15, cc = c & 31, ob = rr * 64 + cc * 2; return st * 1024 + (ob ^ (((ob >> 9) & 1) << 5)); }
__host__ __device__ __forceinline__ void stage_rc(int b, int& R, int& C) { const int st = b / 1024, sb = b % 1024, swz = sb ^ (((sb >> 9) & 1) << 5); R = (st >> 1) * 16 + swz / 64; C = (st & 1) * 32 + (swz % 64) / 2; }
__host__ __device__ __forceinline__ int perm32(int rho) { const int n = rho >> 4, i = rho & 15; return 8 * (i >> 2) + 4 * n + (i & 3); }

struct Unit { int pm, pn; };
struct Gemm { const bf16_t* A; const bf16_t* Bt; int M, N, K; };

struct StaticOrder {
    int nM, nN, nwg, G, c;
    __host__ __device__ void init(int M, int N, int G_, int c_) { nM = M / BM; nN = N / BM; nwg = nM * nN; G = G_; c = c_; }
    __host__ __device__ bool next(int i, Unit& u) const {
        const long L = (long)i * G + c; if (L >= nwg) return false;
        int wgid = (int)L; { const int q = nwg / NXCD, r = nwg % NXCD, xcd = wgid % NXCD, off = wgid / NXCD; wgid = (xcd < r ? xcd * (q + 1) : r * (q + 1) + (xcd - r) * q) + off; }
        const int nig = WGM * nN, gid = wgid / nig, fm = gid * WGM, gsz = (nM - fm) < WGM ? (nM - fm) : WGM;
        u.pm = fm + ((wgid % nig) % gsz); u.pn = (wgid % nig) / gsz; return true;
    }
    __device__ __forceinline__ void a_ready(const Unit&) const {}
    __device__ __forceinline__ void done(const Unit&) const {}
};

__device__ __forceinline__ unsigned cvt_pk_bf16(float lo, float hi) { unsigned r; asm volatile("v_cvt_pk_bf16_f32 %0, %1, %2" : "=v"(r) : "v"(lo), "v"(hi)); return r; }
template <class Epi, class Sched, bool ALIGN_EPI = false, bool SP2 = false>
__device__ __forceinline__ void gemm_phase(PG8_LAS unsigned char* lds, const Gemm g, const Sched& S, const Epi& E) {
    int tid_ = threadIdx.x; asm volatile("" : "+v"(tid_));
    const int tid = tid_, wid = __builtin_amdgcn_readfirstlane(tid >> 6), lane = tid & 63, wr = wid >> 2, wc = wid & 3, fr = lane & 15, fq = lane >> 4;
    const int K = g.K, nt = K / BK;
    unsigned voffA[2], voffB[2];
#pragma unroll
    for (int i = 0; i < 2; ++i) { int R, C; stage_rc(tid * 16 + i * 8192, R, C); const int Rb = Epi::PERM ? ((R & ~31) + perm32(R & 31)) : R;
        voffA[i] = (unsigned)(R * K + C) * 2u; voffB[i] = (unsigned)(Rb * K + C) * 2u; }
    const size_t kstep = (size_t)(BK * 2);
    const size_t hstep = (size_t)HALF * K * 2;
    const size_t tstep = 2 * hstep;
    const unsigned ldsw = (unsigned)wid * 1024u;
    const int aoff = lds_byte(wr * 64 + fr, fq * 8), boff = lds_byte(wc * 32 + fr, fq * 8);
#define PG8_SA(b, h) (((b) * 2 + (h)) * HTB)
#define PG8_SB(b, h) ((4 + (b) * 2 + (h)) * HTB)
#define PG8_STAGE(bufoff, gbase, voff) do { _Pragma("unroll") for (int _i = 0; _i < 2; ++_i) \
        __builtin_amdgcn_global_load_lds((const unsigned*)((const char*)(gbase) + (voff)[_i]), (PG8_LAS unsigned*)(lds + (bufoff) + ldsw + _i * 8192), 16, 0, 0); } while (0)
#define PG8_LDA(dst, b, h) do { _Pragma("unroll") for (int m = 0; m < 4; ++m) _Pragma("unroll") for (int k = 0; k < 2; ++k) dst[m][k] = *(const PG8_LAS bf16x8*)(lds + PG8_SA(b, h) + aoff + m * 2048 + k * 1024); } while (0)
#define PG8_LDB(dst, b, h) do { _Pragma("unroll") for (int n = 0; n < 2; ++n) _Pragma("unroll") for (int k = 0; k < 2; ++k) dst[n][k] = *(const PG8_LAS bf16x8*)(lds + PG8_SB(b, h) + boff + n * 2048 + k * 1024); } while (0)
#define PG8_MMA(ai, bj, At, Bt) do { __builtin_amdgcn_s_setprio(1); _Pragma("unroll") for (int m = 0; m < 4; ++m) _Pragma("unroll") for (int n = 0; n < 2; ++n) _Pragma("unroll") for (int k = 0; k < 2; ++k) \
        acc[ai][bj][m][n] = __builtin_amdgcn_mfma_f32_16x16x32_bf16(Bt[n][k], At[m][k], acc[ai][bj][m][n], 0, 0, 0); __builtin_amdgcn_s_setprio(0); } while (0)
#define PG8_WAIT_V(n) asm volatile("s_waitcnt vmcnt(" #n ")" ::: "memory")
#define PG8_WAIT_L(n) asm volatile("s_waitcnt lgkmcnt(" #n ")" ::: "memory")
#define PG8_BAR __builtin_amdgcn_s_barrier()
#define PG8_SCHED __builtin_amdgcn_sched_barrier(0)
    Unit cur, nxt; int ui = 0;
    if (!S.next(0, cur)) return;
    f32x4 acc[2][2][4][2];
#pragma unroll
    for (int a = 0; a < 2; ++a)
#pragma unroll
        for (int b = 0; b < 2; ++b)
#pragma unroll
            for (int m = 0; m < 4; ++m)
#pragma unroll
                for (int n = 0; n < 2; ++n) acc[a][b][m][n] = (f32x4){0.f, 0.f, 0.f, 0.f};
    bf16x8 At[4][2], B0[2][2], B1[2][2];
    const char* cA = (const char*)g.A + (size_t)cur.pm * tstep; const char* cB = (const char*)g.Bt + (size_t)cur.pn * tstep;
    S.a_ready(cur);
    if constexpr (SP2) {
        PG8_STAGE(PG8_SB(0, 0), cB, voffB); PG8_STAGE(PG8_SB(0, 1), cB + hstep, voffB); PG8_STAGE(PG8_SA(0, 0), cA, voffA); PG8_STAGE(PG8_SA(0, 1), cA + hstep, voffA);
        if (wr == 1) PG8_BAR;
        PG8_WAIT_V(2); PG8_BAR;
        PG8_STAGE(PG8_SB(1, 0), cB + kstep, voffB); PG8_STAGE(PG8_SA(1, 0), cA + kstep, voffA); PG8_STAGE(PG8_SB(1, 1), cB + hstep + kstep, voffB);
        PG8_WAIT_V(6); PG8_BAR;
    } else {
        PG8_STAGE(PG8_SB(0, 0), cB, voffB); PG8_STAGE(PG8_SA(0, 0), cA, voffA); PG8_STAGE(PG8_SB(0, 1), cB + hstep, voffB); PG8_STAGE(PG8_SA(0, 1), cA + hstep, voffA);
        if (wr == 1) PG8_BAR;
        PG8_WAIT_V(4); PG8_BAR;
        PG8_STAGE(PG8_SB(1, 0), cB + kstep, voffB); PG8_STAGE(PG8_SA(1, 0), cA + kstep, voffA); PG8_STAGE(PG8_SB(1, 1), cB + hstep + kstep, voffB);
        PG8_WAIT_V(6); PG8_BAR;
    }
    for (;;) {
        const bool has_next = S.next(ui + 1, nxt);
        const char* nA = has_next ? (const char*)g.A + (size_t)nxt.pm * tstep : cA; const char* nB = has_next ? (const char*)g.Bt + (size_t)nxt.pn * tstep : cB;
        for (int t = 0; t < nt; t += 2) {
            const bool last = (t == nt - 2);
            const char* a1 = cA + (size_t)(t + 1) * kstep;
            const char* a2 = last ? nA : cA + (size_t)(t + 2) * kstep; const char* b2 = last ? nB : cB + (size_t)(t + 2) * kstep;
            const char* a3 = a2 + kstep; const char* b3 = b2 + kstep;
            if (last && has_next) S.a_ready(nxt);
            if constexpr (SP2) {
            PG8_LDB(B0, 0, 0); PG8_LDB(B1, 0, 1); PG8_SCHED; PG8_LDA(At, 0, 0); PG8_STAGE(PG8_SA(1, 1), a1 + hstep, voffA);
            PG8_WAIT_V(8); PG8_WAIT_L(0); PG8_BAR; PG8_MMA(0, 0, At, B0); PG8_MMA(0, 1, At, B1); PG8_BAR; PG8_SCHED;
            PG8_LDA(At, 0, 1); PG8_STAGE(PG8_SB(0, 0), b2, voffB); PG8_STAGE(PG8_SB(0, 1), b2 + hstep, voffB); PG8_STAGE(PG8_SA(0, 0), a2, voffA);
            PG8_WAIT_V(8); PG8_WAIT_L(0); PG8_BAR; PG8_MMA(1, 0, At, B0); PG8_MMA(1, 1, At, B1); PG8_BAR; PG8_SCHED;
            PG8_LDB(B0, 1, 0); PG8_LDB(B1, 1, 1); PG8_SCHED; PG8_LDA(At, 1, 0); PG8_STAGE(PG8_SA(0, 1), a2 + hstep, voffA);
            PG8_WAIT_V(8); PG8_WAIT_L(0); PG8_BAR; PG8_MMA(0, 0, At, B0); PG8_MMA(0, 1, At, B1); PG8_BAR; PG8_SCHED;
            PG8_LDA(At, 1, 1); PG8_STAGE(PG8_SB(1, 0), b3, voffB); PG8_STAGE(PG8_SB(1, 1), b3 + hstep, voffB); PG8_STAGE(PG8_SA(1, 0), a3, voffA);
            PG8_WAIT_V(8); PG8_WAIT_L(0); PG8_BAR; PG8_MMA(1, 0, At, B0); PG8_MMA(1, 1, At, B1); PG8_BAR; PG8_SCHED;
            } else {
            PG8_LDB(B0, 0, 0); PG8_SCHED; PG8_LDA(At, 0, 0); PG8_STAGE(PG8_SA(1, 1), a1 + hstep, voffA);
            PG8_WAIT_L(8); PG8_BAR; PG8_WAIT_L(0); PG8_MMA(0, 0, At, B0); PG8_BAR; PG8_SCHED;
            PG8_LDB(B1, 0, 1); PG8_STAGE(PG8_SB(0, 0), b2, voffB);
            PG8_BAR; PG8_WAIT_L(0); PG8_MMA(0, 1, At, B1); PG8_BAR;
            PG8_LDA(At, 0, 1); PG8_STAGE(PG8_SA(0, 0), a2, voffA);
            PG8_BAR; PG8_WAIT_L(0); PG8_MMA(1, 0, At, B0); PG8_BAR; PG8_SCHED;
            PG8_STAGE(PG8_SB(0, 1), b2 + hstep, voffB);
            PG8_WAIT_V(6); PG8_BAR; PG8_MMA(1, 1, At, B1); PG8_BAR;
            PG8_LDB(B0, 1, 0); PG8_SCHED; PG8_LDA(At, 1, 0); PG8_STAGE(PG8_SA(0, 1), a2 + hstep, voffA);
            PG8_WAIT_L(8); PG8_BAR; PG8_WAIT_L(0); PG8_MMA(0, 0, At, B0); PG8_BAR; PG8_SCHED;
            PG8_LDB(B1, 1, 1); PG8_STAGE(PG8_SB(1, 0), b3, voffB);
            PG8_BAR; PG8_WAIT_L(0); PG8_MMA(0, 1, At, B1); PG8_BAR;
            PG8_LDA(At, 1, 1); PG8_STAGE(PG8_SA(1, 0), a3, voffA);
            PG8_BAR; PG8_WAIT_L(0); PG8_MMA(1, 0, At, B0); PG8_BAR; PG8_SCHED;
            PG8_STAGE(PG8_SB(1, 1), b3 + hstep, voffB);
            PG8_WAIT_V(6); PG8_BAR; PG8_MMA(1, 1, At, B1); PG8_BAR;
            }
        }
        if constexpr (ALIGN_EPI) { if (wr == 0) PG8_BAR; }
        if constexpr (!Epi::AFTER_DRAIN) { E(acc, cur, wr, wc, fr, fq); S.done(cur); }
        if (!has_next) break;
#pragma unroll
        for (int a = 0; a < 2; ++a)
#pragma unroll
            for (int b = 0; b < 2; ++b)
#pragma unroll
                for (int m = 0; m < 4; ++m)
#pragma unroll
                    for (int n = 0; n < 2; ++n) acc[a][b][m][n] = (f32x4){0.f, 0.f, 0.f, 0.f};
        cur = nxt; cA = nA; cB = nB; ++ui;
        if constexpr (ALIGN_EPI) { if (wr == 1) PG8_BAR; }
    }
    PG8_WAIT_V(0);
    if constexpr (!ALIGN_EPI) { if (wr == 0) PG8_BAR; }
    PG8_BAR;
    if constexpr (Epi::AFTER_DRAIN) { E.fused(acc, cur, wr, wc, fr, fq, lds, wid, lane); S.done(cur); }
#undef PG8_SA
#undef PG8_SB
#undef PG8_STAGE
#undef PG8_LDA
#undef PG8_LDB
#undef PG8_MMA
#undef PG8_WAIT_V
#undef PG8_WAIT_L
#undef PG8_BAR
#undef PG8_SCHED
}
}

using pg8::bf16_t; using pg8::bf16x8; using pg8::f32x4; using pg8::u32x4; using pg8::Unit;
typedef __bf16 bf16x2_t __attribute__((ext_vector_type(2)));
typedef float f32x2_t __attribute__((ext_vector_type(2)));
__device__ __forceinline__ unsigned cvt_pk_bf16(float lo, float hi) { const f32x2_t v = {lo, hi}; const bf16x2_t b = __builtin_convertvector(v, bf16x2_t); return __builtin_bit_cast(unsigned, b); }
typedef short s16x4 __attribute__((ext_vector_type(4)));
typedef unsigned u32x2 __attribute__((ext_vector_type(2)));
#define LAS __attribute__((address_space(3)))
constexpr int DM = 1024, DEPTH = 4, DFF = 2816, ZN = 6912, INC = 6784;
constexpr int MC = 32768;
constexpr int NCHUNK = 3;
constexpr int NQKH = 28, QKP = NQKH * 64;
constexpr float LOG2E = 1.4426950408889634f;
constexpr int LUTN = 8192, LUTOFF = 4096;
constexpr size_t MiB = 1u << 20;
constexpr size_t WS_LUT = 0, WS_GT = 512 * 1024, WS_PT = 768 * 1024, WS_W = 1 * MiB, WL = 35 * MiB;
constexpr size_t W_IN = 0, W_PA = 14155776, W_PB = 15204352, W_PC = 15990784, W_O = 17039360, W_GU = 19136512, W_DN = 30670848, W_SGU = 36438016;
static_assert(W_SGU + 8 * 128 * 128 * 2 == WL, "weight map");
constexpr size_t WS_XB = 141 * MiB, WS_ZU = 205 * MiB, WS_ZV = 237 * MiB, WS_QK = 269 * MiB, WS_VTB = 381 * MiB, WS_VTC = 405 * MiB, WS_GATE = 437 * MiB;
constexpr size_t WS_AOUT = 629 * MiB, WS_BOUT = 661 * MiB, WS_COUT = 685 * MiB, WS_MERGED = 717 * MiB, WS_SS1 = 781 * MiB, WS_SS2 = 783 * MiB, WS_LB = 785 * MiB, WS_XB2 = 786 * MiB, WS_END = 850 * MiB;
constexpr size_t WS_MF32 = WS_QK, WS_HID = WS_GATE;
static_assert(WS_W + 4 * WL == WS_XB && WS_QK + (size_t)MC * QKP * 2 == WS_VTB && WS_VTB + (size_t)MC * 384 * 2 == WS_VTC && WS_VTC + (size_t)MC * 512 * 2 == WS_GATE, "ws map");
static_assert(WS_MF32 + (size_t)MC * 1024 * 4 <= WS_GATE && WS_HID + (size_t)MC * DFF * 2 <= WS_AOUT && WS_GATE + (size_t)MC * 3072 * 2 == WS_AOUT, "ws alias map");
constexpr int PT_L = 4096, PT_SUBG = 0, PT_LNG = 128, PT_LNB = 640, PT_SGUB = 1152, PT_LAM = 2176;
constexpr int LDS_BYTES = 147456;
constexpr int NSTEPS = 1 + NCHUNK * DEPTH * 6;

struct Args { const float* in[25]; float* out; unsigned char* ws; int lo, hi; };
enum { I_XP = 0, I_XS, I_RELB, I_N1G, I_WIN, I_LNG, I_LNB, I_SGUW, I_SGUB, I_QNB, I_KNB, I_QNC, I_KNC, I_LQ1, I_LK1, I_LQ2, I_LK2, I_SUBG, I_WPA, I_WPB, I_WPC, I_WO, I_N2G, I_WGU, I_WDN };

__device__ __forceinline__ float bflo(unsigned w) { return __uint_as_float(w << 16); }
__device__ __forceinline__ float bfhi(unsigned w) { return __uint_as_float(w & 0xffff0000u); }
__device__ __forceinline__ float fexp2(float x) { return __builtin_amdgcn_exp2f(x); }
__device__ __forceinline__ float frcp(float x) { return __builtin_amdgcn_rcpf(x); }
__device__ __forceinline__ float sigmoidf_(float x) { return frcp(1.f + fexp2(-LOG2E * x)); }
__device__ __forceinline__ float gelu_tanh(float x) { const float u = 0.7978845608028654f * (x + 0.044715f * x * x * x); return x * frcp(1.f + fexp2(-2.f * LOG2E * u)); }
__device__ __forceinline__ float shx(float v, int lane, int o) { return __builtin_bit_cast(float, __builtin_amdgcn_ds_bpermute((lane ^ o) << 2, __builtin_bit_cast(int, v))); }
__device__ __forceinline__ float wave_sum(float v, int lane) {
#pragma unroll
    for (int o = 1; o < 64; o <<= 1) v += shx(v, lane, o);
    return v;
}
__device__ __forceinline__ float quad_sum(float v, int lane) { v += shx(v, lane, 16); v += shx(v, lane, 32); return v; }
__device__ __forceinline__ unsigned cvt_pk_asm(float lo, float hi) { unsigned r; asm volatile("s_nop 1\n\tv_cvt_pk_bf16_f32 %0, %1, %2" : "=v"(r) : "v"(lo), "v"(hi)); return r; }
__device__ __forceinline__ u32x4 pack8(const float* v) { u32x4 w; w.x = cvt_pk_asm(v[0], v[1]); w.y = cvt_pk_asm(v[2], v[3]); w.z = cvt_pk_asm(v[4], v[5]); w.w = cvt_pk_asm(v[6], v[7]); return w; }
__device__ __forceinline__ float ss_total(const float* ssp, size_t row) {
    float t = 0.f;
#pragma unroll
    for (int pn = 0; pn < 4; ++pn) { const f32x4 v = *(const f32x4*)(ssp + ((size_t)pn * MC + row) * 4); t += (v[0] + v[1]) + (v[2] + v[3]); }
    return t;
}
__device__ __forceinline__ void unit_row_scales(float (&rs)[2][4], const float* ssp, LAS float* rsb, int pm, int wr, int wc, int fr, int fq) {
    const int t = (wr * 4 + wc) * 64 + fq * 16 + fr;
    if (t < 256) rsb[t] = rsqrtf(ss_total(ssp, (size_t)pm * 256 + t) * (1.f / 1024.f) + 1e-6f);
    asm volatile("s_waitcnt lgkmcnt(0)" ::: "memory"); __builtin_amdgcn_s_barrier(); asm volatile("" ::: "memory");
#pragma unroll
    for (int ai = 0; ai < 2; ++ai)
#pragma unroll
        for (int m = 0; m < 4; ++m) rs[ai][m] = rsb[ai * 128 + wr * 64 + m * 16 + fr];
}
#define MFMA16(a, b, c) __builtin_amdgcn_mfma_f32_16x16x32_bf16((a), (b), (c), 0, 0, 0)

struct EpiWin {
    static constexpr bool PERM = true, AFTER_DRAIN = false;
    unsigned char* ws; int l, lgS; LAS float* rsb;
    __device__ __forceinline__ void operator()(const f32x4 (&acc)[2][2][4][2], const Unit& u, int wr, int wc, int fr, int fq) const {
        const int row0 = u.pm * 256 + wr * 64 + fr, pn = u.pn;
        const float* ss1 = (const float*)(ws + WS_SS1);
        float rs[2][4];
        unit_row_scales(rs, ss1, rsb, u.pm, wr, wc, fr, fq);
        if (pn < 4) {
            bf16_t* base = (bf16_t*)(ws + (pn < 2 ? WS_ZU : WS_ZV)) + (pn & 1) * 256 + wc * 32 + 8 * fq;
#pragma unroll
            for (int ai = 0; ai < 2; ++ai)
#pragma unroll
                for (int m = 0; m < 4; ++m) { const size_t row = row0 + ai * 128 + m * 16;
#pragma unroll
                    for (int bj = 0; bj < 2; ++bj) { float v[8];
#pragma unroll
                        for (int e = 0; e < 8; ++e) v[e] = gelu_tanh(acc[ai][bj][m][e >> 2][e & 3] * rs[ai][m]);
                        *(u32x4*)(base + row * 512 + bj * 128) = pack8(v); } __builtin_amdgcn_sched_barrier(0); }
        } else if (pn < 11) {
            const int hh = 4 * (pn - 4) + wc;
            const float* gp = (const float*)(ws + WS_GT) + (l * NQKH + hh) * 64;
            float g[2][8];
#pragma unroll
            for (int bj = 0; bj < 2; ++bj)
#pragma unroll
                for (int e = 0; e < 8; ++e) g[bj][e] = gp[32 * bj + 8 * fq + e];
            bf16_t* base = (bf16_t*)(ws + WS_QK) + hh * 64 + 8 * fq;
#pragma unroll
            for (int ai = 0; ai < 2; ++ai)
#pragma unroll
                for (int m = 0; m < 4; ++m) { const int rown = row0 + ai * 128 + m * 16; float ssq = 0.f;
                    size_t row = rown;
                    if (hh < 12) { const int lgd = 2 * ((hh < 6 ? hh : hh - 6) >> 1), s = rown & ((1 << lgS) - 1), nn = s >> lgd; row = (size_t)(rown - s) + ((((nn >> 4) << lgd) + (s & ((1 << lgd) - 1))) << 4) + (nn & 15); }
#pragma unroll
                    for (int bj = 0; bj < 2; ++bj)
#pragma unroll
                        for (int e = 0; e < 8; ++e) { const float t = acc[ai][bj][m][e >> 2][e & 3] * rs[ai][m]; ssq += t * t; }
                    ssq = quad_sum(ssq, fq * 16 + fr);
                    const float r = rsqrtf(ssq * (1.f / 64.f) + 1e-6f) * rs[ai][m];
#pragma unroll
                    for (int bj = 0; bj < 2; ++bj) { float v[8];
#pragma unroll
                        for (int e = 0; e < 8; ++e) v[e] = acc[ai][bj][m][e >> 2][e & 3] * r * g[bj][e];
                        *(u32x4*)(base + row * QKP + 32 * bj) = pack8(v); } __builtin_amdgcn_sched_barrier(0); }
        } else if (pn < 15) {
            const int S = 1 << lgS;
#pragma unroll
            for (int bj = 0; bj < 2; ++bj) {
                const int vch0 = (pn - 11) * 256 + 128 * bj + 32 * wc + 8 * fq;
                if (vch0 >= 896) continue;
                const bool isB = vch0 < 384; const int lg = isB ? 2 * (vch0 >> 7) : 0;
#pragma unroll
                for (int ai = 0; ai < 2; ++ai)
#pragma unroll
                    for (int m = 0; m < 4; ++m) { const int row = row0 + ai * 128 + m * 16; const int b = row >> lgS, s = row & (S - 1);
                        const int nn = s >> lg, idx = ((((nn >> 4) << lg) + (s & ((1 << lg) - 1))) << 4) + (nn & 15);
                        bf16_t* dst = isB ? (bf16_t*)(ws + WS_VTB) + ((size_t)(b * 384 + vch0) << lgS) + idx : (bf16_t*)(ws + WS_VTC) + ((size_t)(b * 512 + vch0 - 384) << lgS) + s;
#pragma unroll
                        for (int e = 0; e < 8; e += 2) { const unsigned w = cvt_pk_asm(acc[ai][bj][m][e >> 2][e & 3] * rs[ai][m], acc[ai][bj][m][e >> 2][(e & 3) + 1] * rs[ai][m]);
                            dst[(size_t)e << lgS] = (bf16_t)(w & 0xffffu); dst[(size_t)(e + 1) << lgS] = (bf16_t)(w >> 16); } __builtin_amdgcn_sched_barrier(0); }
            }
        } else {
            bf16_t* base = (bf16_t*)(ws + WS_GATE) + (pn - 15) * 256 + wc * 32 + 8 * fq;
#pragma unroll
            for (int ai = 0; ai < 2; ++ai)
#pragma unroll
                for (int m = 0; m < 4; ++m) { const size_t row = row0 + ai * 128 + m * 16;
#pragma unroll
                    for (int bj = 0; bj < 2; ++bj) { float v[8];
#pragma unroll
                        for (int e = 0; e < 8; ++e) v[e] = sigmoidf_(acc[ai][bj][m][e >> 2][e & 3] * rs[ai][m]);
                        *(u32x4*)(base + row * 3072 + bj * 128) = pack8(v); } __builtin_amdgcn_sched_barrier(0); }
        }
    }
};
struct EpiWp {
    static constexpr bool PERM = true, AFTER_DRAIN = false;
    unsigned char* ws; int BR;
    __device__ __forceinline__ void operator()(const f32x4 (&acc)[2][2][4][2], const Unit& u, int wr, int wc, int fr, int fq) const {
        const int row0 = u.pm * 256 + wr * 64 + fr, col0 = u.pn * 256 + wc * 32 + 8 * fq;
        const bf16_t* gate = (const bf16_t*)(ws + WS_GATE); bf16_t* merged = (bf16_t*)(ws + WS_MERGED);
        u32x4 gwv[2][4][2];
#pragma unroll
        for (int ai = 0; ai < 2; ++ai)
#pragma unroll
            for (int m = 0; m < 4; ++m)
#pragma unroll
                for (int bj = 0; bj < 2; ++bj) gwv[ai][m][bj] = *(const u32x4*)(gate + (size_t)(row0 + ai * 128 + m * 16) * 3072 + BR * 1024 + col0 + bj * 128);
        __builtin_amdgcn_sched_barrier(0);
#pragma unroll
        for (int ai = 0; ai < 2; ++ai)
#pragma unroll
            for (int m = 0; m < 4; ++m) { const size_t row = row0 + ai * 128 + m * 16;
#pragma unroll
                for (int bj = 0; bj < 2; ++bj) { const int col = col0 + bj * 128;
                    const u32x4 gw = gwv[ai][m][bj];
                    float v[8];
                    v[0] = bflo(gw.x) * acc[ai][bj][m][0][0]; v[1] = bfhi(gw.x) * acc[ai][bj][m][0][1]; v[2] = bflo(gw.y) * acc[ai][bj][m][0][2]; v[3] = bfhi(gw.y) * acc[ai][bj][m][0][3];
                    v[4] = bflo(gw.z) * acc[ai][bj][m][1][0]; v[5] = bfhi(gw.z) * acc[ai][bj][m][1][1]; v[6] = bflo(gw.w) * acc[ai][bj][m][1][2]; v[7] = bfhi(gw.w) * acc[ai][bj][m][1][3];
                    bf16_t* mp = merged + row * 1024 + col;
                    if (BR > 0) { const u32x4 pm = *(const u32x4*)mp;
                        v[0] += bflo(pm.x); v[1] += bfhi(pm.x); v[2] += bflo(pm.y); v[3] += bfhi(pm.y); v[4] += bflo(pm.z); v[5] += bfhi(pm.z); v[6] += bflo(pm.w); v[7] += bfhi(pm.w); }
                    *(u32x4*)mp = pack8(v); } }
    }
};
struct EpiRes {
    static constexpr bool PERM = true, AFTER_DRAIN = false;
    float* xout; bf16_t* xb; float* ss; int next;
    __device__ __forceinline__ void operator()(const f32x4 (&acc)[2][2][4][2], const Unit& u, int wr, int wc, int fr, int fq) const {
        const int row0 = u.pm * 256 + wr * 64 + fr, col0 = u.pn * 256 + wc * 32 + 8 * fq;
        u32x4 xwv[2][4][2];
#pragma unroll
        for (int ai = 0; ai < 2; ++ai)
#pragma unroll
            for (int m = 0; m < 4; ++m)
#pragma unroll
                for (int bj = 0; bj < 2; ++bj) xwv[ai][m][bj] = *(const u32x4*)(xb + (size_t)(row0 + ai * 128 + m * 16) * 1024 + col0 + bj * 128);
        __builtin_amdgcn_sched_barrier(0);
#pragma unroll
        for (int ai = 0; ai < 2; ++ai)
#pragma unroll
            for (int m = 0; m < 4; ++m) { const size_t row = row0 + ai * 128 + m * 16; float part = 0.f;
#pragma unroll
                for (int bj = 0; bj < 2; ++bj) { const int col = col0 + bj * 128;
                    const u32x4 xw = xwv[ai][m][bj];
                    float v[8];
                    v[0] = bflo(xw.x) + acc[ai][bj][m][0][0]; v[1] = bfhi(xw.x) + acc[ai][bj][m][0][1]; v[2] = bflo(xw.y) + acc[ai][bj][m][0][2]; v[3] = bfhi(xw.y) + acc[ai][bj][m][0][3];
                    v[4] = bflo(xw.z) + acc[ai][bj][m][1][0]; v[5] = bfhi(xw.z) + acc[ai][bj][m][1][1]; v[6] = bflo(xw.w) + acc[ai][bj][m][1][2]; v[7] = bfhi(xw.w) + acc[ai][bj][m][1][3];
                    if (next) { *(u32x4*)(xb + row * 1024 + col) = pack8(v);
#pragma unroll
                        for (int e = 0; e < 8; ++e) part += v[e] * v[e]; }
                    else { *(f32x4*)(xout + row * 1024 + col) = (f32x4){v[0], v[1], v[2], v[3]}; *(f32x4*)(xout + row * 1024 + col + 4) = (f32x4){v[4], v[5], v[6], v[7]}; } }
                if (next) { part = quad_sum(part, fq * 16 + fr); if (fq == 0) ss[((size_t)u.pn * MC + row) * 4 + wc] = part; } }
    }
};
struct EpiGu {
    static constexpr bool PERM = true, AFTER_DRAIN = false;
    const float* ss2; bf16_t* hid; LAS float* rsb;
    __device__ __forceinline__ void operator()(const f32x4 (&acc)[2][2][4][2], const Unit& u, int wr, int wc, int fr, int fq) const {
        const int row0 = u.pm * 256 + wr * 64 + fr, col0 = u.pn * 128 + wc * 32 + 8 * fq;
        float rsv[2][4];
        unit_row_scales(rsv, ss2, rsb, u.pm, wr, wc, fr, fq);
#pragma unroll
        for (int ai = 0; ai < 2; ++ai)
#pragma unroll
            for (int m = 0; m < 4; ++m) { const size_t row = row0 + ai * 128 + m * 16;
                const float rs = rsv[ai][m]; float v[8];
#pragma unroll
                for (int e = 0; e < 8; ++e) { const float g = acc[ai][0][m][e >> 2][e & 3] * rs, uu = acc[ai][1][m][e >> 2][e & 3] * rs; v[e] = g * sigmoidf_(g) * uu; }
                *(u32x4*)(hid + row * DFF + col0) = pack8(v); }
    }
};

__device__ __forceinline__ int win_src(int n) {
    const int t = n >> 8, w = n & 255;
    if (t < 4) return n;
    if (t < 11) { const int hh = 4 * (t - 4) + ((w & 127) >> 5), d = (w >> 7) * 32;
        const int base = hh < 6 ? 1024 + hh * 64 : hh < 12 ? 1408 + (hh - 6) * 64 : hh < 20 ? 2176 + (hh - 12) * 64 : 2688 + (hh - 20) * 64; return base + d; }
    if (t < 15) { const int v = (t - 11) * 256 + w; return v < 384 ? 1792 + v : v < 896 ? 3200 + (v - 384) : -1; }
    return 3712 + (t - 15) * 256 + w;
}
__device__ __forceinline__ int wgu_src(int n) { const int t = n >> 8, w = n & 255; return w < 128 ? t * 128 + w : DFF + t * 128 + (w - 128); }
__device__ __forceinline__ void cvt_item(const float* W, int K, int N, bf16_t* WT, const float* rscale, int src0, int n0, int k0, LAS float* scr, int lane) {
    if (src0 < 0) {
        const int c = lane & 7;
#pragma unroll
        for (int j = 0; j < 4; ++j) { const int n = (lane >> 3) + 8 * j; *(u32x4*)(WT + (size_t)(n0 + n) * K + k0 + 8 * c) = (u32x4){0u, 0u, 0u, 0u}; }
        return;
    }
#pragma unroll 8
    for (int i = 0; i < 32; ++i) { const int kk = 2 * i + (lane >> 5); float v = W[(size_t)(k0 + kk) * N + src0 + (lane & 31)]; if (rscale) v *= rscale[k0 + kk]; scr[kk * 33 + (lane & 31)] = v; }
    asm volatile("s_waitcnt lgkmcnt(0)" ::: "memory");
    const int c = lane & 7;
#pragma unroll
    for (int j = 0; j < 4; ++j) { const int n = (lane >> 3) + 8 * j; const LAS float* s = scr + (8 * c) * 33 + n;
        u32x4 o; o.x = cvt_pk_bf16(s[0 * 33], s[1 * 33]); o.y = cvt_pk_bf16(s[2 * 33], s[3 * 33]); o.z = cvt_pk_bf16(s[4 * 33], s[5 * 33]); o.w = cvt_pk_bf16(s[6 * 33], s[7 * 33]);
        *(u32x4*)(WT + (size_t)(n0 + n) * K + k0 + 8 * c) = o; }
    asm volatile("s_waitcnt lgkmcnt(0)" ::: "memory");
}
__device__ __forceinline__ int rel_bucket(int rel) {
    const int n = rel < 0 ? -rel : rel; int b;
    if (n < 8) b = n; else b = 8 + (n >= 15) + (n >= 27) + (n >= 50) + (n >= 91) + (n >= 166) + (n >= 305) + (n >= 559);
    return b + (rel > 0 ? 16 : 0);
}
__device__ __forceinline__ void prep_chunk(const float* x, bf16_t* xb, float* ss1, int gw, int ngw, int lane) {
    for (int r0 = gw * 16; r0 < MC; r0 += ngw * 16) {
        float mine = 0.f;
        for (int k = 0; k < 16; ++k) { const int r = r0 + k;
            const f32x4* xr = (const f32x4*)(x + (size_t)r * 1024) + lane; float s = 0.f; f32x4 v[4];
#pragma unroll
            for (int j = 0; j < 4; ++j) { v[j] = xr[64 * j]; s += (v[j][0] * v[j][0] + v[j][1] * v[j][1]) + (v[j][2] * v[j][2] + v[j][3] * v[j][3]); }
            s = wave_sum(s, lane);
            u32x2* o = (u32x2*)(xb + (size_t)r * 1024) + lane;
#pragma unroll
            for (int j = 0; j < 4; ++j) o[64 * j] = (u32x2){cvt_pk_bf16(v[j][0], v[j][1]), cvt_pk_bf16(v[j][2], v[j][3])};
            if (lane == k) mine = s; }
        if (lane < 16) {
#pragma unroll
            for (int pn = 0; pn < 4; ++pn) *(f32x4*)(ss1 + ((size_t)pn * MC + r0 + lane) * 4) = (f32x4){pn == 0 ? mine : 0.f, 0.f, 0.f, 0.f}; }
    }
}
__device__ __forceinline__ void prologue(const Args& a, unsigned char* ws, LAS unsigned char* lds, int gw, int ngw, int wave, int lane) {
    LAS float* scr = (LAS float*)(lds + wave * 8448);
    constexpr int I0 = 3456, I1 = I0 + 256, I2 = I1 + 192, I3 = I2 + 256, I4 = I3 + 512, I5 = I4 + 2816, I6 = I5 + 1408;
    for (int it = gw; it < DEPTH * I6; it += ngw) {
        const int l = it / I6; int r = it % I6; unsigned char* wl = ws + WS_W + (size_t)l * WL;
        if (r < I0) { const int kb = r / 216, nb = r % 216; cvt_item(a.in[I_WIN] + (size_t)l * 1024 * INC, 1024, INC, (bf16_t*)(wl + W_IN), a.in[I_N1G] + l * 1024, win_src(nb * 32), nb * 32, kb * 64, scr, lane); continue; }
        if (r < I1) { r -= I0; const int kb = r / 32, nb = r % 32; cvt_item(a.in[I_WPA] + (size_t)l * 512 * 1024, 512, 1024, (bf16_t*)(wl + W_PA), nullptr, nb * 32, nb * 32, kb * 64, scr, lane); continue; }
        if (r < I2) { r -= I1; const int kb = r / 32, nb = r % 32; cvt_item(a.in[I_WPB] + (size_t)l * 384 * 1024, 384, 1024, (bf16_t*)(wl + W_PB), nullptr, nb * 32, nb * 32, kb * 64, scr, lane); continue; }
        if (r < I3) { r -= I2; const int kb = r / 32, nb = r % 32; cvt_item(a.in[I_WPC] + (size_t)l * 512 * 1024, 512, 1024, (bf16_t*)(wl + W_PC), nullptr, nb * 32, nb * 32, kb * 64, scr, lane); continue; }
        if (r < I4) { r -= I3; const int kb = r / 32, nb = r % 32; cvt_item(a.in[I_WO] + (size_t)l * 1024 * 1024, 1024, 1024, (bf16_t*)(wl + W_O), nullptr, nb * 32, nb * 32, kb * 64, scr, lane); continue; }
        if (r < I5) { r -= I4; const int kb = r / 176, nb = r % 176; cvt_item(a.in[I_WGU] + (size_t)l * 1024 * 2 * DFF, 1024, 2 * DFF, (bf16_t*)(wl + W_GU), a.in[I_N2G] + l * 1024, wgu_src(nb * 32), nb * 32, kb * 64, scr, lane); continue; }
        { r -= I5; const int kb = r / 32, nb = r % 32; cvt_item(a.in[I_WDN] + (size_t)l * DFF * 1024, DFF, 1024, (bf16_t*)(wl + W_DN), nullptr, nb * 32, nb * 32, kb * 64, scr, lane); }
    }
    for (int i = gw * 64 + lane; i < DEPTH * 8 * 128 * 128 / 8; i += ngw * 64) {
        const int l = i / (8 * 128 * 128 / 8), r = i % (8 * 128 * 128 / 8);
        const f32x4 p = *(const f32x4*)(a.in[I_SGUW] + (size_t)i * 8), q = *(const f32x4*)(a.in[I_SGUW] + (size_t)i * 8 + 4);
        *(u32x4*)((bf16_t*)(ws + WS_W + (size_t)l * WL + W_SGU) + (size_t)r * 8) = (u32x4){cvt_pk_bf16(p[0], p[1]), cvt_pk_bf16(p[2], p[3]), cvt_pk_bf16(q[0], q[1]), cvt_pk_bf16(q[2], q[3])};
    }
    float* lut = (float*)(ws + WS_LUT);
    for (int i = gw * 64 + lane; i < 10 * LUTN; i += ngw * 64) { const int h = i / LUTN, rel = (i % LUTN) - LUTOFF; lut[i] = a.in[I_RELB][rel_bucket(rel) * 10 + h] * LOG2E; }
    float* pt = (float*)(ws + WS_PT);
    for (int i = gw * 64 + lane; i < DEPTH * 2176; i += ngw * 64) { const int l = i / 2176, r = i % 2176;
        pt[l * PT_L + r] = r < 128 ? a.in[I_SUBG][l * 128 + r] : r < 640 ? a.in[I_LNG][l * 512 + r - 128] : r < 1152 ? a.in[I_LNB][l * 512 + r - 640] : a.in[I_SGUB][l * 1024 + r - 1152]; }
    if (gw < DEPTH) { const int l = gw;
        const float s1 = wave_sum(a.in[I_LQ1][l * 64 + lane] * a.in[I_LK1][l * 64 + lane], lane), s2 = wave_sum(a.in[I_LQ2][l * 64 + lane] * a.in[I_LK2][l * 64 + lane], lane);
        const float lam_init = 0.8f - 0.6f * expf(-0.3f * (float)l);
        if (lane == 0) { pt[l * PT_L + PT_LAM] = expf(s1) - expf(s2) + lam_init; pt[l * PT_L + PT_LAM + 1] = lam_init; } }
    float* gt = (float*)(ws + WS_GT);
    for (int i = gw * 64 + lane; i < DEPTH * NQKH * 64; i += ngw * 64) { const int l = i / (NQKH * 64), hh = (i / 64) % NQKH, d = i % 64;
        const float* gp = hh < 6 ? a.in[I_QNB] : hh < 12 ? a.in[I_KNB] : hh < 20 ? a.in[I_QNC] : a.in[I_KNC];
        gt[i] = gp[l * 64 + d] * ((hh < 6 || (hh >= 12 && hh < 20)) ? 0.125f * LOG2E : 1.f); }
    prep_chunk(a.in[I_XP], (bf16_t*)(ws + WS_XB), (float*)(ws + WS_SS1), gw, ngw, lane);
}

constexpr int DA_KB = 16384, DA_STG = 32768;
__device__ __forceinline__ void diffattn_item(unsigned char* ws, LAS unsigned char* lds, int l, int lgS, int b, int h, int qb, int tid, int wave, int lane, bool load_lut) {
    const int S = 1 << lgS, T = S >> 6;
    LAS float* lut = (LAS float*)lds;
    LAS unsigned char* stg = lds + 32768;
    const int ql = lane & 15, quad = lane >> 4, q0 = qb * 128 + wave * 16;
    const bf16_t* qkb = (const bf16_t*)(ws + WS_QK) + ((size_t)b << lgS) * QKP;
    const bf16_t* kg[2]; const bf16_t* vg[2];
#pragma unroll
    for (int i = 0; i < 2; ++i) { const int P = (i * 8 + wave) * 64 + lane, key = P >> 4, seg = (P & 15) ^ (key & 15), e = P >> 3, part = (P & 7) ^ ((e >> 1) & 7);
        kg[i] = qkb + (size_t)key * QKP + (20 + (seg >> 3) * 4 + h) * 64 + (seg & 7) * 8;
        vg[i] = (const bf16_t*)(ws + WS_VTC) + ((size_t)(b * 512 + h * 128 + e) << lgS) + part * 8; }
#define DA_DMA(tt, sidx) do { _Pragma("unroll") for (int i = 0; i < 2; ++i) { \
        __builtin_amdgcn_global_load_lds((const unsigned*)(kg[i] + (size_t)(tt) * 64 * QKP), (LAS unsigned*)(stg + (sidx) * DA_STG + (i * 8 + wave) * 1024), 16, 0, 0); \
        __builtin_amdgcn_global_load_lds((const unsigned*)(vg[i] + (tt) * 64), (LAS unsigned*)(stg + (sidx) * DA_STG + DA_KB + (i * 8 + wave) * 1024), 16, 0, 0); } } while (0)
    DA_DMA(0, 0); DA_DMA(1, 1);
    if (load_lut) { const float* glut = (const float*)(ws + WS_LUT) + (6 + h) * LUTN;
      for (int i = tid; i < LUTN; i += 512) lut[i] = glut[i]; }
    bf16x8 qf[2][2];
#pragma unroll
    for (int c = 0; c < 2; ++c)
#pragma unroll
        for (int ks = 0; ks < 2; ++ks) qf[c][ks] = *(const bf16x8*)(qkb + (size_t)(q0 + ql) * QKP + (12 + c * 4 + h) * 64 + 32 * ks + 8 * quad);
    f32x4 o[2][8];
#pragma unroll
    for (int c = 0; c < 2; ++c)
#pragma unroll
        for (int dt = 0; dt < 8; ++dt) o[c][dt] = (f32x4){0.f, 0.f, 0.f, 0.f};
    float lsum0 = 0.f, lsum1 = 0.f;
    const LAS float* lutq = lut + LUTOFF - (q0 + ql) + 4 * quad;
    int kfo[2][2], vfo[2][2];
#pragma unroll
    for (int c = 0; c < 2; ++c)
#pragma unroll
        for (int ks = 0; ks < 2; ++ks) kfo[c][ks] = ql * 256 + (((c * 8 + ks * 4 + quad) ^ ql) << 4);
#pragma unroll
    for (int hf = 0; hf < 2; ++hf)
#pragma unroll
        for (int x = 0; x < 2; ++x) vfo[hf][x] = DA_KB + ql * 128 + (((4 * hf + (quad >> 1) + 2 * x) ^ ((ql >> 1) & 7)) << 4) + 8 * (quad & 1);
    asm volatile("s_waitcnt vmcnt(4) lgkmcnt(0)" ::: "memory"); __builtin_amdgcn_s_barrier(); asm volatile("" ::: "memory");
#define DA_LDK(sbp, hf_) do { _Pragma("unroll") for (int kt = 0; kt < 2; ++kt) _Pragma("unroll") for (int c = 0; c < 2; ++c) _Pragma("unroll") for (int ks = 0; ks < 2; ++ks) \
        kf[kt][c][ks] = *(const LAS bf16x8*)((sbp) + (32 * (hf_) + 16 * kt) * 256 + kfo[c][ks]); } while (0)
#define DA_LDB(k0_) do { _Pragma("unroll") for (int kt = 0; kt < 2; ++kt) _Pragma("unroll") for (int j = 0; j < 4; ++j) biasv[kt][j] = lutq[(k0_) + 16 * kt + j]; } while (0)
    bf16x8 kf[2][2][2]; f32x4 biasv[2];
    DA_LDK(stg, 0); DA_LDB(0);
    int s0 = 0;
    for (int t = 0; t < T; ++t) {
        const int s1 = s0 == 2 ? 0 : s0 + 1, s2 = s1 == 2 ? 0 : s1 + 1;
        if (t + 2 < T) DA_DMA(t + 2, s2);
        const LAS unsigned char* sb = stg + s0 * DA_STG;
#pragma unroll
        for (int hf = 0; hf < 2; ++hf) {
            f32x4 st[2][2];
#pragma unroll
            for (int kt = 0; kt < 2; ++kt)
#pragma unroll
                for (int c = 0; c < 2; ++c) { f32x4 z = MFMA16(kf[kt][c][0], qf[c][0], biasv[kt]); st[c][kt] = MFMA16(kf[kt][c][1], qf[c][1], z); }
            __builtin_amdgcn_sched_barrier(0);
            s16x4 v0[4], v1[4], w0[4], w1[4];
#pragma unroll
            for (int dt = 0; dt < 4; ++dt) { v0[dt] = *(const LAS s16x4*)(sb + dt * 2048 + vfo[hf][0]); v1[dt] = *(const LAS s16x4*)(sb + dt * 2048 + vfo[hf][1]); }
            if (hf == 0) DA_LDK(sb, 1);
            __builtin_amdgcn_sched_barrier(0);
#pragma unroll
            for (int kt = 0; kt < 2; ++kt)
#pragma unroll
                for (int j = 0; j < 4; ++j) { const float p0 = fexp2(st[0][kt][j]), p1 = fexp2(st[1][kt][j]); lsum0 += p0; lsum1 += p1; st[0][kt][j] = p0; st[1][kt][j] = p1; }
            bf16x8 pf[2];
#pragma unroll
            for (int c = 0; c < 2; ++c) { u32x4 w; w.x = cvt_pk_bf16(st[c][0][0], st[c][0][1]); w.y = cvt_pk_bf16(st[c][0][2], st[c][0][3]); w.z = cvt_pk_bf16(st[c][1][0], st[c][1][1]); w.w = cvt_pk_bf16(st[c][1][2], st[c][1][3]);
                pf[c] = __builtin_bit_cast(bf16x8, w); }
            __builtin_amdgcn_sched_barrier(0);
#pragma unroll
            for (int dt = 0; dt < 4; ++dt) { w0[dt] = *(const LAS s16x4*)(sb + (dt + 4) * 2048 + vfo[hf][0]); w1[dt] = *(const LAS s16x4*)(sb + (dt + 4) * 2048 + vfo[hf][1]); }
            if (hf == 0) DA_LDB(t * 64 + 32);
#pragma unroll
            for (int dt = 0; dt < 4; ++dt) { const bf16x8 vf = __builtin_shufflevector(v0[dt], v1[dt], 0, 1, 2, 3, 4, 5, 6, 7);
                o[0][dt] = MFMA16(vf, pf[0], o[0][dt]); o[1][dt] = MFMA16(vf, pf[1], o[1][dt]); }
            __builtin_amdgcn_sched_barrier(0);
#pragma unroll
            for (int dt = 0; dt < 4; ++dt) { const bf16x8 vf = __builtin_shufflevector(w0[dt], w1[dt], 0, 1, 2, 3, 4, 5, 6, 7);
                o[0][dt + 4] = MFMA16(vf, pf[0], o[0][dt + 4]); o[1][dt + 4] = MFMA16(vf, pf[1], o[1][dt + 4]); }
            __builtin_amdgcn_sched_barrier(0);
        }
        if (t + 2 < T) asm volatile("s_waitcnt vmcnt(4) lgkmcnt(0)" ::: "memory"); else asm volatile("s_waitcnt vmcnt(0) lgkmcnt(0)" ::: "memory");
        __builtin_amdgcn_s_barrier(); asm volatile("" ::: "memory");
        __builtin_amdgcn_sched_barrier(0);
        if (t + 1 < T) { DA_LDK(stg + s1 * DA_STG, 0); DA_LDB((t + 1) * 64); }
        s0 = s1;
    }
#undef DA_LDB
#undef DA_LDK
#undef DA_DMA
    lsum0 = quad_sum(lsum0, lane); lsum1 = quad_sum(lsum1, lane);
    const float* pt = (const float*)(ws + WS_PT) + l * PT_L;
    const float lam = pt[PT_LAM], lam_init = pt[PT_LAM + 1];
    const float i1 = 1.f / lsum0, i2 = lam / lsum1; float ssq = 0.f;
#pragma unroll
    for (int dt = 0; dt < 8; ++dt)
#pragma unroll
        for (int j = 0; j < 4; ++j) { const float v = o[0][dt][j] * i1 - o[1][dt][j] * i2; o[0][dt][j] = v; ssq += v * v; }
    ssq = quad_sum(ssq, lane);
    const float r = rsqrtf(ssq * (1.f / 128.f) + 1e-6f) * (1.f - lam_init);
    bf16_t* outp = (bf16_t*)(ws + WS_COUT) + ((size_t)(b << lgS) + q0 + ql) * 512 + h * 128 + 4 * quad;
    const float* sg = pt + PT_SUBG + 4 * quad;
#pragma unroll
    for (int dt = 0; dt < 8; ++dt) { const f32x4 g = *(const f32x4*)(sg + 16 * dt);
        *(u32x2*)(outp + 16 * dt) = (u32x2){cvt_pk_bf16(o[0][dt][0] * r * g[0], o[0][dt][1] * r * g[1]), cvt_pk_bf16(o[0][dt][2] * r * g[2], o[0][dt][3] * r * g[3])}; }
}

__device__ __forceinline__ void dilattn_item(unsigned char* ws, LAS unsigned char* lds, int lgS, int b, int sp, int j, int tid, int wave, int lane) {
    const int S = 1 << lgS;
    const int ql = lane & 15, quad = lane >> 4;
    const bf16_t* qkb = (const bf16_t*)(ws + WS_QK) + ((size_t)b << lgS) * QKP;
    bf16_t* bout = (bf16_t*)(ws + WS_BOUT) + ((size_t)b << lgS) * 384;
    float* lb = (float*)(ws + WS_LB) + ((size_t)j * MC + ((size_t)b << lgS)) * 4;
    const float* glut = (const float*)(ws + WS_LUT);
    LAS float* lutl = (LAS float*)lds;
#pragma unroll
    for (int i0 = 0; i0 < 3 * 4096; i0 += 512) { const int i = i0 + tid; lutl[i] = glut[(2 * (i >> 12) + j) * LUTN + LUTOFF - 2048 + (i & 4095)]; }
    __syncthreads();
    for (int uu = wave; uu < 48; uu += 8) {
        const int gi = uu >> 4, u = uu & 15, lg = 2 * gi, dil = 1 << lg, r = u & (dil - 1), n0 = (sp << (8 - lg)) + 16 * (u >> lg), L = S >> lg, hh = 2 * gi + j;
        const int tokq = ((n0 + ql) << lg) + r;
        bf16x8 qf[2];
#pragma unroll
        for (int ks = 0; ks < 2; ++ks) qf[ks] = *(const bf16x8*)(qkb + (size_t)(((((n0 >> 4) << lg) + r) << 4) + ql) * QKP + hh * 64 + 32 * ks + 8 * quad);
        f32x4 st[10];
#pragma unroll
        for (int kt = 0; kt < 10; ++kt) { int n = n0 - 64 + 32 * (kt >> 1) + 8 * (ql >> 2) + 4 * (kt & 1) + (ql & 3); n = n < 0 ? 0 : (n > L - 1 ? L - 1 : n);
            const bf16_t* kp = qkb + (size_t)(((((n >> 4) << lg) + r) << 4) + (n & 15)) * QKP + (6 + hh) * 64 + 8 * quad;
            const bf16x8 ka0 = *(const bf16x8*)kp, ka1 = *(const bf16x8*)(kp + 32);
            f32x4 z = (f32x4){0.f, 0.f, 0.f, 0.f}; z = MFMA16(ka0, qf[0], z); st[kt] = MFMA16(ka1, qf[1], z); }
        float lsum = 0.f;
        const LAS float* lutp = lutl + gi * 4096 + 2048;
#pragma unroll
        for (int kt = 0; kt < 10; ++kt)
#pragma unroll
            for (int e = 0; e < 4; ++e) { const int n = n0 - 64 + 32 * (kt >> 1) + 8 * quad + 4 * (kt & 1) + e, rel = n - (n0 + ql);
                const bool valid = (n >= 0) && (n < L) && (rel <= 64) && (rel >= -64);
                const float bias = lutp[rel * dil];
                const float p = valid ? fexp2(st[kt][e] + bias) : 0.f; lsum += p; st[kt][e] = p; }
        f32x4 o[4];
#pragma unroll
        for (int dt = 0; dt < 4; ++dt) o[dt] = (f32x4){0.f, 0.f, 0.f, 0.f};
        const bf16_t* vb = (const bf16_t*)(ws + WS_VTB) + ((size_t)(b * 384 + hh * 64 + ql) << lgS);
#pragma unroll
        for (int i = 0; i < 5; ++i) {
            u32x4 w; w.x = cvt_pk_bf16(st[2 * i][0], st[2 * i][1]); w.y = cvt_pk_bf16(st[2 * i][2], st[2 * i][3]); w.z = cvt_pk_bf16(st[2 * i + 1][0], st[2 * i + 1][1]); w.w = cvt_pk_bf16(st[2 * i + 1][2], st[2 * i + 1][3]);
            const bf16x8 pf = __builtin_bit_cast(bf16x8, w);
            int na = n0 - 64 + 32 * i + 8 * quad;
            na = na < 0 ? 0 : (na > L - 8 ? L - 8 : na);
#pragma unroll
            for (int dt = 0; dt < 4; ++dt) { const bf16_t* vp = vb + ((size_t)(dt * 16) << lgS);
                const bf16x8 vf = *(const bf16x8*)(vp + (((((na >> 4) << lg) + r) << 4) + (na & 15)));
                o[dt] = MFMA16(vf, pf, o[dt]); }
        }
        lsum = quad_sum(lsum, lane);
        bf16_t* op = bout + (size_t)tokq * 384 + hh * 64 + 4 * quad;
#pragma unroll
        for (int dt = 0; dt < 4; ++dt) *(u32x2*)(op + 16 * dt) = (u32x2){cvt_pk_bf16(o[dt][0], o[dt][1]), cvt_pk_bf16(o[dt][2], o[dt][3])};
        if (quad == 0) lb[(size_t)tokq * 4 + gi] = lsum;
    }
    asm volatile("s_waitcnt vmcnt(0)" ::: "memory"); __builtin_amdgcn_fence(__ATOMIC_SEQ_CST, "workgroup"); __syncthreads(); __builtin_amdgcn_fence(__ATOMIC_SEQ_CST, "workgroup");
    for (int idx = tid; idx < 256 * 24; idx += 512) {
        const int tok = sp * 256 + idx / 24, rem = idx % 24, gi = rem >> 3, piece = rem & 7, hh = 2 * gi + j;
        const f32x4 lp = *(const f32x4*)(lb + (size_t)tok * 4);
        const float inv = 1.f / (lp[0] + lp[1] + lp[2]);
        u32x4* p = (u32x4*)(bout + (size_t)tok * 384 + hh * 64 + piece * 8); const u32x4 w = *p;
        u32x4 o; o.x = cvt_pk_bf16(bflo(w.x) * inv, bfhi(w.x) * inv); o.y = cvt_pk_bf16(bflo(w.y) * inv, bfhi(w.y) * inv); o.z = cvt_pk_bf16(bflo(w.z) * inv, bfhi(w.z) * inv); o.w = cvt_pk_bf16(bflo(w.w) * inv, bfhi(w.w) * inv);
        *p = o;
    }
    __syncthreads();
}

__device__ __forceinline__ void sgu_item(unsigned char* ws, LAS unsigned char* lds, int l, int ci, int tid, int wave, int lane) {
    const float* ptab = (const float*)(ws + WS_PT) + l * PT_L;
    typedef float f32x2 __attribute__((ext_vector_type(2)));
    LAS f32x2* stats = (LAS f32x2*)lds;
    LAS unsigned char* img = lds + 1024 + wave * 17408;
    const bf16_t* zv = (const bf16_t*)(ws + WS_ZV) + (size_t)ci * 128 * 512;
    const bf16_t* zu = (const bf16_t*)(ws + WS_ZU) + (size_t)ci * 128 * 512;
    bf16_t* aout = (bf16_t*)(ws + WS_AOUT) + (size_t)ci * 128 * 512;
#pragma unroll
    for (int t = 0; t < 16; ++t) { const int tok = wave * 16 + t;
        const u32x4 w = *(const u32x4*)(zv + (size_t)tok * 512 + lane * 8);
        float v[8] = {bflo(w.x), bfhi(w.x), bflo(w.y), bfhi(w.y), bflo(w.z), bfhi(w.z), bflo(w.w), bfhi(w.w)};
        float s = 0.f;
#pragma unroll
        for (int e = 0; e < 8; ++e) s += v[e];
        const float mean = wave_sum(s, lane) * (1.f / 512.f); float s2 = 0.f;
#pragma unroll
        for (int e = 0; e < 8; ++e) { const float d = v[e] - mean; s2 += d * d; }
        const float rstd = rsqrtf(wave_sum(s2, lane) * (1.f / 512.f) + 1e-5f);
        if (lane == 0) stats[tok] = (f32x2){mean, rstd}; }
    __syncthreads();
    const int g = wave;
    { const int tl = lane >> 3, cp = lane & 7; float gam[8], bet[8];
#pragma unroll
      for (int e = 0; e < 8; ++e) { gam[e] = ptab[PT_LNG + g * 64 + 8 * cp + e]; bet[e] = ptab[PT_LNB + g * 64 + 8 * cp + e]; }
#pragma unroll
      for (int it = 0; it < 16; ++it) { const int tok = 8 * it + tl; const f32x2 ms = stats[tok];
          const u32x4 w = *(const u32x4*)(zv + (size_t)tok * 512 + g * 64 + 8 * cp);
          float v[8] = {bflo(w.x), bfhi(w.x), bflo(w.y), bfhi(w.y), bflo(w.z), bfhi(w.z), bflo(w.w), bfhi(w.w)};
#pragma unroll
          for (int e = 0; e < 8; ++e) v[e] = (v[e] - ms[0]) * ms[1] * gam[e] + bet[e];
          LAS unsigned char* dp = img + tok * 136 + (cp >> 2) * 64 + (cp & 3) * 8;
          *(LAS u32x2*)dp = (u32x2){cvt_pk_bf16(v[0], v[1]), cvt_pk_bf16(v[2], v[3])}; *(LAS u32x2*)(dp + 32) = (u32x2){cvt_pk_bf16(v[4], v[5]), cvt_pk_bf16(v[6], v[7])}; } }
    __syncthreads();
    const int ql = lane & 15, quad = lane >> 4;
    typedef short v4i16_t __attribute__((ext_vector_type(4)));
    bf16x8 af[4][4];
#pragma unroll
    for (int dt = 0; dt < 4; ++dt)
#pragma unroll
        for (int ks = 0; ks < 4; ++ks) {
            const LAS unsigned char* p0 = img + (32 * ks + 8 * quad + (ql >> 2)) * 136 + 32 * dt + 8 * (ql & 3);
            const s16x4 t0 = __builtin_bit_cast(s16x4, __builtin_amdgcn_ds_read_tr16_b64_v4i16((LAS v4i16_t*)p0));
            const s16x4 t1 = __builtin_bit_cast(s16x4, __builtin_amdgcn_ds_read_tr16_b64_v4i16((LAS v4i16_t*)(p0 + 4 * 136)));
            af[dt][ks] = __builtin_shufflevector(t0, t1, 0, 1, 2, 3, 4, 5, 6, 7); }
    const bf16_t* wg = (const bf16_t*)(ws + WS_W + (size_t)l * WL + W_SGU) + (size_t)g * 128 * 128;
#pragma unroll 2
    for (int pt = 0; pt < 8; ++pt) {
        f32x4 acc[4];
#pragma unroll
        for (int dt = 0; dt < 4; ++dt) acc[dt] = (f32x4){0.f, 0.f, 0.f, 0.f};
#pragma unroll
        for (int ks = 0; ks < 4; ++ks) { const bf16x8 bfr = *(const bf16x8*)(wg + (size_t)(16 * pt + ql) * 128 + 32 * ks + 8 * quad);
#pragma unroll
            for (int dt = 0; dt < 4; ++dt) acc[dt] = MFMA16(af[dt][ks], bfr, acc[dt]); }
        const int tok = 16 * pt + ql; const float bias = ptab[PT_SGUB + g * 128 + tok];
#pragma unroll
        for (int k = 0; k < 2; ++k) { const int col = g * 64 + 32 * k + 8 * quad;
            const u32x4 uw = *(const u32x4*)(zu + (size_t)tok * 512 + col);
            u32x4 ow;
            ow.x = cvt_pk_bf16(bflo(uw.x) * (acc[2 * k][0] + bias), bfhi(uw.x) * (acc[2 * k][1] + bias)); ow.y = cvt_pk_bf16(bflo(uw.y) * (acc[2 * k][2] + bias), bfhi(uw.y) * (acc[2 * k][3] + bias));
            ow.z = cvt_pk_bf16(bflo(uw.z) * (acc[2 * k + 1][0] + bias), bfhi(uw.z) * (acc[2 * k + 1][1] + bias)); ow.w = cvt_pk_bf16(bflo(uw.w) * (acc[2 * k + 1][2] + bias), bfhi(uw.w) * (acc[2 * k + 1][3] + bias));
            *(u32x4*)(aout + (size_t)tok * 512 + col) = ow; }
    }
    __syncthreads();
}

#ifndef PHM
#define PHM 127
#endif
#ifndef IM
#define IM 7
#endif
#define GRID_SYNC() do { asm volatile("s_waitcnt vmcnt(0)" ::: "memory"); __syncthreads(); \
    grid.sync(); \
    if (threadIdx.x < 64) { __builtin_amdgcn_fence(__ATOMIC_ACQUIRE, "agent"); asm volatile("s_waitcnt vmcnt(0)" ::: "memory"); } __syncthreads(); } while (0)
__global__ void __launch_bounds__(512, 2) fwd(Args a) {
    extern __shared__ __attribute__((aligned(16))) unsigned char lds_raw[];
    LAS unsigned char* lds = (LAS unsigned char*)lds_raw;
    cg::grid_group grid = cg::this_grid();
    int s = a.lo;
    if (s == 0) {
        unsigned char* ws = a.ws; int tid = threadIdx.x, bx = blockIdx.x, G = gridDim.x;
        const int lane = tid & 63, wave = __builtin_amdgcn_readfirstlane(tid >> 6), gw = bx * 8 + wave, ngw = G * 8;
        if (PHM & 1) prologue(a, ws, lds, gw, ngw, wave, lane);
        ++s; if (s < a.hi) GRID_SYNC();
    }
#ifdef PROBE_P
    int probe_rep = 0;
#ifdef PROBE_IM
#define PROBE_SEL(x) (!probe_rep || (PROBE_IM & (x)))
#else
#define PROBE_SEL(x) true
#endif
#else
#define PROBE_SEL(x) true
#endif
    for (; s < a.hi; ++s) {
        size_t zo = 0; int bx = blockIdx.x, G = gridDim.x;
        asm volatile("" : "+s"(zo), "+s"(bx), "+s"(G));
        unsigned char* ws = a.ws + zo;
        const int t = s - 1, c = t / 24, l = (t % 24) / 6, p = t % 6;
        const int lgS = c < 2 ? 11 : 12;
        unsigned char* wl = ws + WS_W + (size_t)l * WL;
        const size_t xbo = (c & 1) ? WS_XB2 : WS_XB, xbn = (c & 1) ? WS_XB : WS_XB2;
        if (p == 0 && (PHM & 2)) {
            pg8::Gemm g{(const bf16_t*)(ws + xbo), (const bf16_t*)(wl + W_IN), MC, ZN, 1024}; pg8::StaticOrder S; S.init(MC, ZN, G, bx);
            EpiWin E{ws, l, lgS, (LAS float*)(lds + 131072)};
            pg8::gemm_phase<EpiWin, pg8::StaticOrder, true, true>(lds, g, S, E);
        } else if (p == 1 && (PHM & 4)) {
            int tid = threadIdx.x; asm volatile("" : "+v"(tid));
            const int lane = tid & 63, wave = __builtin_amdgcn_readfirstlane(tid >> 6);
            const int nqb = (1 << lgS) / 128, NC = (MC / 128) * 4, NB = (MC / 256) * 2, NA = MC / 128;
            {
            const int vbx = (G & 7) == 0 ? (bx & 7) * (G >> 3) + (bx >> 3) : bx;
            if ((IM & 1) && PROBE_SEL(1)) { int lut_h = -1; for (int it = vbx; it < NC; it += G) { const int qb = it % nqb, bh = it / nqb; diffattn_item(ws, lds, l, lgS, bh >> 2, bh & 3, qb, tid, wave, lane, (bh & 3) != lut_h); lut_h = bh & 3; } }
            if ((IM & 2) && PROBE_SEL(2)) for (int it = bx; it < NB; it += G) { const int j = it & 1, gsp = it >> 1, nsp = (1 << lgS) / 256; dilattn_item(ws, lds, lgS, gsp / nsp, gsp % nsp, j, tid, wave, lane); }
            if ((IM & 4) && PROBE_SEL(4)) for (int it = bx; it < NA; it += G) sgu_item(ws, lds, l, it, tid, wave, lane);
            }
        } else if (p == 2 && (PHM & 8)) {
            pg8::StaticOrder S; S.init(MC, 1024, G, bx);
#pragma nounroll
            for (int br = 0; br < 3; ++br) {
                const size_t aoff = br == 0 ? WS_AOUT : br == 1 ? WS_BOUT : WS_COUT, woff = br == 0 ? W_PA : br == 1 ? W_PB : W_PC;
                pg8::Gemm g{(const bf16_t*)(ws + aoff), (const bf16_t*)(wl + woff), MC, 1024, br == 1 ? 384 : 512}; EpiWp E{ws, br};
                pg8::gemm_phase<EpiWp, pg8::StaticOrder, true, true>(lds, g, S, E);
            }
        } else if ((p == 3 && (PHM & 16)) || (p == 5 && (PHM & 64))) {
            float* xout = a.out + (size_t)c * MC * 1024 + zo;
            const bool wo = p == 3;
            pg8::Gemm g{(const bf16_t*)(ws + (wo ? WS_MERGED : WS_HID)), (const bf16_t*)(wl + (wo ? W_O : W_DN)), MC, 1024, wo ? 1024 : DFF}; pg8::StaticOrder S; S.init(MC, 1024, G, bx);
            EpiRes E{xout, (bf16_t*)(ws + xbo), (float*)(ws + (wo ? WS_SS2 : WS_SS1)), (wo || l < DEPTH - 1) ? 1 : 0};
            pg8::gemm_phase<EpiRes, pg8::StaticOrder, true, true>(lds, g, S, E);
            if (!wo && l == DEPTH - 1 && c + 1 < NCHUNK) {
                int tid = threadIdx.x; asm volatile("" : "+v"(tid));
                const int lane = tid & 63, wave = __builtin_amdgcn_readfirstlane(tid >> 6);
                const float* xn = ((c + 1) < 2 ? a.in[I_XP] + (size_t)(c + 1) * MC * 1024 : a.in[I_XS]) + zo;
                prep_chunk(xn, (bf16_t*)(ws + xbn), (float*)(ws + WS_SS1), bx * 8 + wave, G * 8, lane);
            }
        } else if (p == 4 && (PHM & 32)) {
            pg8::Gemm g{(const bf16_t*)(ws + xbo), (const bf16_t*)(wl + W_GU), MC, 2 * DFF, 1024}; pg8::StaticOrder S; S.init(MC, 2 * DFF, G, bx);
            EpiGu E{(const float*)(ws + WS_SS2), (bf16_t*)(ws + WS_HID), (LAS float*)(lds + 131072)};
            pg8::gemm_phase<EpiGu, pg8::StaticOrder, true, true>(lds, g, S, E);
        }
        if (s + 1 < a.hi) GRID_SYNC();
#ifdef PROBE_P
        if (p == PROBE_P && !probe_rep) { probe_rep = 1; --s; } else probe_rep = 0;
#endif
    }
}

#ifndef MK_MULTI
#define MK_MULTI 0
#endif
extern "C" void kernel_launch(void* const* d_in, const int* in_sizes, int n_in, void* d_out, int out_size, void* d_ws, size_t ws_size, hipStream_t stream) {
    static int grid = 0;
    if (grid == 0) {
        if (n_in != 25 || ws_size < WS_END) { fprintf(stderr, "kernel_launch: need 25 inputs and %zu bytes of workspace (got %d, %zu)\n", (size_t)WS_END, n_in, ws_size); grid = -1; return; }
        int dev = 0, cus = 0, per_cu = 0;
        if (hipGetDevice(&dev) != hipSuccess || hipDeviceGetAttribute(&cus, hipDeviceAttributeMultiprocessorCount, dev) != hipSuccess) { grid = -1; return; }
        if (hipFuncSetAttribute((const void*)fwd, hipFuncAttributeMaxDynamicSharedMemorySize, LDS_BYTES) != hipSuccess) { fprintf(stderr, "kernel_launch: hipFuncSetAttribute failed\n"); grid = -1; return; }
        if (hipOccupancyMaxActiveBlocksPerMultiprocessor(&per_cu, (const void*)fwd, 512, LDS_BYTES) != hipSuccess || per_cu < 1) per_cu = 1;
        (void)hipGetLastError();
        grid = cus * per_cu;
        fprintf(stderr, "kernel_launch: grid %d (%d CUs x %d), ws %zu\n", grid, cus, per_cu, ws_size);
    }
    if (grid < 0) return;
    Args a{};
    for (int i = 0; i < 25; ++i) a.in[i] = (const float*)d_in[i];
    a.out = (float*)d_out; a.ws = (unsigned char*)d_ws;
#if MK_MULTI
    for (int s = 0; s < NSTEPS; ++s) { a.lo = s; a.hi = s + 1; void* args[] = {&a};
        hipError_t e = hipLaunchCooperativeKernel((const void*)fwd, dim3(grid), dim3(512), args, LDS_BYTES, stream);
        if (e != hipSuccess) { fprintf(stderr, "kernel_launch: launch %d failed: %s\n", s, hipGetErrorString(e)); break; } }
#else
    a.lo = 0; a.hi = NSTEPS; void* args[] = {&a};
    hipError_t e = hipLaunchCooperativeKernel((const void*)fwd, dim3(grid), dim3(512), args, LDS_BYTES, stream);
    if (e != hipSuccess) fprintf(stderr, "kernel_launch: cooperative launch failed: %s (grid %d)\n", hipGetErrorString(e), grid);
#endif
}
```

```cpp
#include <hip/hip_runtime.h>
#include <hip/hip_cooperative_groups.h>
#include <cstdio>
#include <cstdint>
namespace cg = cooperative_groups;
namespace pg8 {
#define PG8_LAS __attribute__((address_space(3)))
typedef unsigned short bf16_t;
typedef short bf16x8 __attribute__((ext_vector_type(8)));
typedef float f32x4 __attribute__((ext_vector_type(4)));
typedef unsigned u32x4 __attribute__((ext_vector_type(4)));
constexpr int BM = 256, BK = 64, HALF = 128, HTB = HALF * BK * 2  , STAGE_BYTES = 8 * HTB, NXCD = 8, WGM = 4;

__host__ __device__ __forceinline__ int lds_byte(int r, int c) { const int st = (r >> 4) * 2 + (c >> 5), rr = r & 15, cc = c & 31, ob = rr * 64 + cc * 2; return st * 1024 + (ob ^ (((ob >> 9) & 1) << 5)); }
__host__ __device__ __forceinline__ void stage_rc(int b, int& R, int& C) { const int st = b / 1024, sb = b % 1024, swz = sb ^ (((sb >> 9) & 1) << 5); R = (st >> 1) * 16 + swz / 64; C = (st & 1) * 32 + (swz % 64) / 2; }
__host__ __device__ __forceinline__ int perm32(int rho) { const int n = rho >> 4, i = rho & 15; return 8 * (i >> 2) + 4 * n + (i & 3); }

struct Unit { int pm, pn; };
struct Gemm { const bf16_t* A; const bf16_t* Bt; int M, N, K; };

struct StaticOrder {
    int nM, nN, nwg, G, c;
    __host__ __device__ void init(int M, int N, int G_, int c_) { nM = M / BM; nN = N / BM; nwg = nM * nN; G = G_; c = c_; }
    __host__ __device__ bool next(int i, Unit& u) const {
        const long L = (long)i * G + c; if (L >= nwg) return false;
        int wgid = (int)L; { const int q = nwg / NXCD, r = nwg % NXCD, xcd = wgid % NXCD, off = wgid / NXCD; wgid = (xcd < r ? xcd * (q + 1) : r * (q + 1) + (xcd - r) * q) + off; }
        const int nig = WGM * nN, gid = wgid / nig, fm = gid * WGM, gsz = (nM - fm) < WGM ? (nM - fm) : WGM;
        u.pm = fm + ((wgid % nig) % gsz); u.pn = (wgid % nig) / gsz; return true;
    }
    __device__ __forceinline__ void a_ready(const Unit&) const {}
    __device__ __forceinline__ void done(const Unit&) const {}
};

__device__ __forceinline__ unsigned cvt_pk_bf16(float lo, float hi) { unsigned r; asm volatile("v_cvt_pk_bf16_f32 %0, %1, %2" : "=v"(r) : "v"(lo), "v"(hi)); return r; }
template <class Epi, class Sched, bool ALIGN_EPI = false, bool SP2 = false>
__device__ __forceinline__ void gemm_phase(PG8_LAS unsigned char* lds, const Gemm g, const Sched& S, const Epi& E) {
    int tid_ = threadIdx.x; asm volatile("" : "+v"(tid_));
    const int tid = tid_, wid = __builtin_amdgcn_readfirstlane(tid >> 6), lane = tid & 63, wr = wid >> 2, wc = wid & 3, fr = lane & 15, fq = lane >> 4;
    const int K = g.K, nt = K / BK;
    unsigned voffA[2], voffB[2];
#pragma unroll
    for (int i = 0; i < 2; ++i) { int R, C; stage_rc(tid * 16 + i * 8192, R, C); const int Rb = Epi::PERM ? ((R & ~31) + perm32(R & 31)) : R;
        voffA[i] = (unsigned)(R * K + C) * 2u; voffB[i] = (unsigned)(Rb * K + C) * 2u; }
    const size_t kstep = (size_t)(BK * 2);
    const size_t hstep = (size_t)HALF * K * 2;
    const size_t tstep = 2 * hstep;
    const unsigned ldsw = (unsigned)wid * 1024u;
    const int aoff = lds_byte(wr * 64 + fr, fq * 8), boff = lds_byte(wc * 32 + fr, fq * 8);
#define PG8_SA(b, h) (((b) * 2 + (h)) * HTB)
#define PG8_SB(b, h) ((4 + (b) * 2 + (h)) * HTB)
#define PG8_STAGE(bufoff, gbase, voff) do { _Pragma("unroll") for (int _i = 0; _i < 2; ++_i) \
        __builtin_amdgcn_global_load_lds((const unsigned*)((const char*)(gbase) + (voff)[_i]), (PG8_LAS unsigned*)(lds + (bufoff) + ldsw + _i * 8192), 16, 0, 0); } while (0)
#define PG8_LDA(dst, b, h) do { _Pragma("unroll") for (int m = 0; m < 4; ++m) _Pragma("unroll") for (int k = 0; k < 2; ++k) dst[m][k] = *(const PG8_LAS bf16x8*)(lds + PG8_SA(b, h) + aoff + m * 2048 + k * 1024); } while (0)
#define PG8_LDB(dst, b, h) do { _Pragma("unroll") for (int n = 0; n < 2; ++n) _Pragma("unroll") for (int k = 0; k < 2; ++k) dst[n][k] = *(const PG8_LAS bf16x8*)(lds + PG8_SB(b, h) + boff + n * 2048 + k * 1024); } while (0)
#define PG8_MMA(ai, bj, At, Bt) do { __builtin_amdgcn_s_setprio(1); _Pragma("unroll") for (int m = 0; m < 4; ++m) _Pragma("unroll") for (int n = 0; n < 2; ++n) _Pragma("unroll") for (int k = 0; k < 2; ++k) \
        acc[ai][bj][m][n] = __builtin_amdgcn_mfma_f32_16x16x32_bf16(Bt[n][k], At[m][k], acc[ai][bj][m][n], 0, 0, 0); __builtin_amdgcn_s_setprio(0); } while (0)
#define PG8_WAIT_V(n) asm volatile("s_waitcnt vmcnt(" #n ")" ::: "memory")
#define PG8_WAIT_L(n) asm volatile("s_waitcnt lgkmcnt(" #n ")" ::: "memory")
#define PG8_BAR __builtin_amdgcn_s_barrier()
#define PG8_SCHED __builtin_amdgcn_sched_barrier(0)
    Unit cur, nxt; int ui = 0;
    if (!S.next(0, cur)) return;
    f32x4 acc[2][2][4][2];
#pragma unroll
    for (int a = 0; a < 2; ++a)
#pragma unroll
        for (int b = 0; b < 2; ++b)
#pragma unroll
            for (int m = 0; m < 4; ++m)
#pragma unroll
                for (int n = 0; n < 2; ++n) acc[a][b][m][n] = (f32x4){0.f, 0.f, 0.f, 0.f};
    bf16x8 At[4][2], B0[2][2], B1[2][2];
    const char* cA = (const char*)g.A + (size_t)cur.pm * tstep; const char* cB = (const char*)g.Bt + (size_t)cur.pn * tstep;
    S.a_ready(cur);
    if constexpr (SP2) {
        PG8_STAGE(PG8_SB(0, 0), cB, voffB); PG8_STAGE(PG8_SB(0, 1), cB + hstep, voffB); PG8_STAGE(PG8_SA(0, 0), cA, voffA); PG8_STAGE(PG8_SA(0, 1), cA + hstep, voffA);
        if (wr == 1) PG8_BAR;
        PG8_WAIT_V(2); PG8_BAR;
        PG8_STAGE(PG8_SB(1, 0), cB + kstep, voffB); PG8_STAGE(PG8_SA(1, 0), cA + kstep, voffA); PG8_STAGE(PG8_SB(1, 1), cB + hstep + kstep, voffB);
        PG8_WAIT_V(6); PG8_BAR;
    } else {
        PG8_STAGE(PG8_SB(0, 0), cB, voffB); PG8_STAGE(PG8_SA(0, 0), cA, voffA); PG8_STAGE(PG8_SB(0, 1), cB + hstep, voffB); PG8_STAGE(PG8_SA(0, 1), cA + hstep, voffA);
        if (wr == 1) PG8_BAR;
        PG8_WAIT_V(4); PG8_BAR;
        PG8_STAGE(PG8_SB(1, 0), cB + kstep, voffB); PG8_STAGE(PG8_SA(1, 0), cA + kstep, voffA); PG8_STAGE(PG8_SB(1, 1), cB + hstep + kstep, voffB);
        PG8_WAIT_V(6); PG8_BAR;
    }
    for (;;) {
        const bool has_next = S.next(ui + 1, nxt);
        const char* nA = has_next ? (const char*)g.A + (size_t)nxt.pm * tstep : cA; const char* nB = has_next ? (const char*)g.Bt + (size_t)nxt.pn * tstep : cB;
        for (int t = 0; t < nt; t += 2) {
            const bool last = (t == nt - 2);
            const char* a1 = cA + (size_t)(t + 1) * kstep;
            const char* a2 = last ? nA : cA + (size_t)(t + 2) * kstep; const char* b2 = last ? nB : cB + (size_t)(t + 2) * kstep;
            const char* a3 = a2 + kstep; const char* b3 = b2 + kstep;
            if (last && has_next) S.a_ready(nxt);
            if constexpr (SP2) {
            PG8_LDB(B0, 0, 0); PG8_LDB(B1, 0, 1); PG8_SCHED; PG8_LDA(At, 0, 0); PG8_STAGE(PG8_SA(1, 1), a1 + hstep, voffA);
            PG8_WAIT_V(8); PG8_WAIT_L(0); PG8_BAR; PG8_MMA(0, 0, At, B0); PG8_MMA(0, 1, At, B1); PG8_BAR; PG8_SCHED;
            PG8_LDA(At, 0, 1); PG8_STAGE(PG8_SB(0, 0), b2, voffB); PG8_STAGE(PG8_SB(0, 1), b2 + hstep, voffB); PG8_STAGE(PG8_SA(0, 0), a2, voffA);
            PG8_WAIT_V(8); PG8_WAIT_L(0); PG8_BAR; PG8_MMA(1, 0, At, B0); PG8_MMA(1, 1, At, B1); PG8_BAR; PG8_SCHED;
            PG8_LDB(B0, 1, 0); PG8_LDB(B1, 1, 1); PG8_SCHED; PG8_LDA(At, 1, 0); PG8_STAGE(PG8_SA(0, 1), a2 + hstep, voffA);
            PG8_WAIT_V(8); PG8_WAIT_L(0); PG8_BAR; PG8_MMA(0, 0, At, B0); PG8_MMA(0, 1, At, B1); PG8_BAR; PG8_SCHED;
            PG8_LDA(At, 1, 1); PG8_STAGE(PG8_SB(1, 0), b3, voffB); PG8_STAGE(PG8_SB(1, 1), b3 + hstep, voffB); PG8_STAGE(PG8_SA(1, 0), a3, voffA);
            PG8_WAIT_V(8); PG8_WAIT_L(0); PG8_BAR; PG8_MMA(1, 0, At, B0); PG8_MMA(1, 1, At, B1); PG8_BAR; PG8_SCHED;
            } else {
            PG8_LDB(B0, 0, 0); PG8_SCHED; PG8_LDA(At, 0, 0); PG8_STAGE(PG8_SA(1, 1), a1 + hstep, voffA);
            PG8_WAIT_L(8); PG8_BAR; PG8_WAIT_L(0); PG8_MMA(0, 0, At, B0); PG8_BAR; PG8_SCHED;
            PG8_LDB(B1, 0, 1); PG8_STAGE(PG8_SB(0, 0), b2, voffB);
            PG8_BAR; PG8_WAIT_L(0); PG8_MMA(0, 1, At, B1); PG8_BAR;
            PG8_LDA(At, 0, 1); PG8_STAGE(PG8_SA(0, 0), a2, voffA);
            PG8_BAR; PG8_WAIT_L(0); PG8_MMA(1, 0, At, B0); PG8_BAR; PG8_SCHED;
            PG8_STAGE(PG8_SB(0, 1), b2 + hstep, voffB);
            PG8_WAIT_V(6); PG8_BAR; PG8_MMA(1, 1, At, B1); PG8_BAR;
            PG8_LDB(B0, 1, 0); PG8_SCHED; PG8_LDA(At, 1, 0); PG8_STAGE(PG8_SA(0, 1), a2 + hstep, voffA);
            PG8_WAIT_L(8); PG8_BAR; PG8_WAIT_L(0); PG8_MMA(0, 0, At, B0); PG8_BAR; PG8_SCHED;
            PG8_LDB(B1, 1, 1); PG8_STAGE(PG8_SB(1, 0), b3, voffB);
            PG8_BAR; PG8_WAIT_L(0); PG8_MMA(0, 1, At, B1); PG8_BAR;
            PG8_LDA(At, 1, 1); PG8_STAGE(PG8_SA(1, 0), a3, voffA);
            PG8_BAR; PG8_WAIT_L(0); PG8_MMA(1, 0, At, B0); PG8_BAR; PG8_SCHED;
            PG8_STAGE(PG8_SB(1, 1), b3 + hstep, voffB);
            PG8_WAIT_V(6); PG8_BAR; PG8_MMA(1, 1, At, B1); PG8_BAR;
            }
        }
        if constexpr (ALIGN_EPI) { if (wr == 0) PG8_BAR; }
        if constexpr (!Epi::AFTER_DRAIN) { E(acc, cur, wr, wc, fr, fq); S.done(cur); }
        if (!has_next) break;
#pragma unroll
        for (int a = 0; a < 2; ++a)
#pragma unroll
            for (int b = 0; b < 2; ++b)
#pragma unroll
                for (int m = 0; m < 4; ++m)
#pragma unroll
                    for (int n = 0; n < 2; ++n) acc[a][b][m][n] = (f32x4){0.f, 0.f, 0.f, 0.f};
        cur = nxt; cA = nA; cB = nB; ++ui;
        if constexpr (ALIGN_EPI) { if (wr == 1) PG8_BAR; }
    }
    PG8_WAIT_V(0);
    if constexpr (!ALIGN_EPI) { if (wr == 0) PG8_BAR; }
    PG8_BAR;
    if constexpr (Epi::AFTER_DRAIN) { E.fused(acc, cur, wr, wc, fr, fq, lds, wid, lane); S.done(cur); }
#undef PG8_SA
#undef PG8_SB
#undef PG8_STAGE
#undef PG8_LDA
#undef PG8_LDB
#undef PG8_MMA
#undef PG8_WAIT_V
#undef PG8_WAIT_L
#undef PG8_BAR
#undef PG8_SCHED
}
}

using pg8::bf16_t; using pg8::bf16x8; using pg8::f32x4; using pg8::u32x4; using pg8::Unit;
typedef __bf16 bf16x2_t __attribute__((ext_vector_type(2)));
typedef float f32x2_t __attribute__((ext_vector_type(2)));
__device__ __forceinline__ unsigned cvt_pk_bf16(float lo, float hi) { const f32x2_t v = {lo, hi}; const bf16x2_t b = __builtin_convertvector(v, bf16x2_t); return __builtin_bit_cast(unsigned, b); }
typedef short s16x4 __attribute__((ext_vector_type(4)));
typedef unsigned u32x2 __attribute__((ext_vector_type(2)));
#define LAS __attribute__((address_space(3)))
constexpr int DM = 1024, DEPTH = 4, DFF = 2816, ZN = 6912, INC = 6784;
constexpr int MC = 32768;
constexpr int NCHUNK = 3;
constexpr int NQKH = 28, QKP = NQKH * 64;
constexpr float LOG2E = 1.4426950408889634f;
constexpr int LUTN = 8192, LUTOFF = 4096;
constexpr size_t MiB = 1u << 20;
constexpr size_t WS_LUT = 0, WS_GT = 512 * 1024, WS_PT = 768 * 1024, WS_W = 1 * MiB, WL = 35 * MiB;
constexpr size_t W_IN = 0, W_PA = 14155776, W_PB = 15204352, W_PC = 15990784, W_O = 17039360, W_GU = 19136512, W_DN = 30670848, W_SGU = 36438016;
static_assert(W_SGU + 8 * 128 * 128 * 2 == WL, "weight map");
constexpr size_t WS_XB = 141 * MiB, WS_ZU = 205 * MiB, WS_ZV = 237 * MiB, WS_QK = 269 * MiB, WS_VTB = 381 * MiB, WS_VTC = 405 * MiB, WS_GATE = 437 * MiB;
constexpr size_t WS_AOUT = 629 * MiB, WS_BOUT = 661 * MiB, WS_COUT = 685 * MiB, WS_MERGED = 717 * MiB, WS_SS1 = 781 * MiB, WS_SS2 = 783 * MiB, WS_LB = 785 * MiB, WS_XB2 = 786 * MiB, WS_END = 850 * MiB;
constexpr size_t WS_MF32 = WS_QK, WS_HID = WS_GATE;
static_assert(WS_W + 4 * WL == WS_XB && WS_QK + (size_t)MC * QKP * 2 == WS_VTB && WS_VTB + (size_t)MC * 384 * 2 == WS_VTC && WS_VTC + (size_t)MC * 512 * 2 == WS_GATE, "ws map");
static_assert(WS_MF32 + (size_t)MC * 1024 * 4 <= WS_GATE && WS_HID + (size_t)MC * DFF * 2 <= WS_AOUT && WS_GATE + (size_t)MC * 3072 * 2 == WS_AOUT, "ws alias map");
constexpr int PT_L = 4096, PT_SUBG = 0, PT_LNG = 128, PT_LNB = 640, PT_SGUB = 1152, PT_LAM = 2176;
constexpr int LDS_BYTES = 147456;
constexpr int NSTEPS = 1 + NCHUNK * DEPTH * 6;

struct Args { const float* in[25]; float* out; unsigned char* ws; int lo, hi; };
enum { I_XP = 0, I_XS, I_RELB, I_N1G, I_WIN, I_LNG, I_LNB, I_SGUW, I_SGUB, I_QNB, I_KNB, I_QNC, I_KNC, I_LQ1, I_LK1, I_LQ2, I_LK2, I_SUBG, I_WPA, I_WPB, I_WPC, I_WO, I_N2G, I_WGU, I_WDN };

__device__ __forceinline__ float bflo(unsigned w) { return __uint_as_float(w << 16); }
__device__ __forceinline__ float bfhi(unsigned w) { return __uint_as_float(w & 0xffff0000u); }
__device__ __forceinline__ float fexp2(float x) { return __builtin_amdgcn_exp2f(x); }
__device__ __forceinline__ float frcp(float x) { return __builtin_amdgcn_rcpf(x); }
__device__ __forceinline__ float sigmoidf_(float x) { return frcp(1.f + fexp2(-LOG2E * x)); }
__device__ __forceinline__ float gelu_tanh(float x) { const float u = 0.7978845608028654f * (x + 0.044715f * x * x * x); return x * frcp(1.f + fexp2(-2.f * LOG2E * u)); }
__device__ __forceinline__ float shx(float v, int lane, int o) { return __builtin_bit_cast(float, __builtin_amdgcn_ds_bpermute((lane ^ o) << 2, __builtin_bit_cast(int, v))); }
__device__ __forceinline__ float wave_sum(float v, int lane) {
#pragma unroll
    for (int o = 1; o < 64; o <<= 1) v += shx(v, lane, o);
    return v;
}
__device__ __forceinline__ float quad_sum(float v, int lane) { v += shx(v, lane, 16); v += shx(v, lane, 32); return v; }
__device__ __forceinline__ unsigned cvt_pk_asm(float lo, float hi) { unsigned r; asm volatile("s_nop 1\n\tv_cvt_pk_bf16_f32 %0, %1, %2" : "=v"(r) : "v"(lo), "v"(hi)); return r; }
__device__ __forceinline__ u32x4 pack8(const float* v) { u32x4 w; w.x = cvt_pk_asm(v[0], v[1]); w.y = cvt_pk_asm(v[2], v[3]); w.z = cvt_pk_asm(v[4], v[5]); w.w = cvt_pk_asm(v[6], v[7]); return w; }
__device__ __forceinline__ float ss_total(const float* ssp, size_t row) {
    float t = 0.f;
#pragma unroll
    for (int pn = 0; pn < 4; ++pn) { const f32x4 v = *(const f32x4*)(ssp + ((size_t)pn * MC + row) * 4); t += (v[0] + v[1]) + (v[2] + v[3]); }
    return t;
}
__device__ __forceinline__ void unit_row_scales(float (&rs)[2][4], const float* ssp, LAS float* rsb, int pm, int wr, int wc, int fr, int fq) {
    const int t = (wr * 4 + wc) * 64 + fq * 16 + fr;
    if (t < 256) rsb[t] = rsqrtf(ss_total(ssp, (size_t)pm * 256 + t) * (1.f / 1024.f) + 1e-6f);
    asm volatile("s_waitcnt lgkmcnt(0)" ::: "memory"); __builtin_amdgcn_s_barrier(); asm volatile("" ::: "memory");
#pragma unroll
    for (int ai = 0; ai < 2; ++ai)
#pragma unroll
        for (int m = 0; m < 4; ++m) rs[ai][m] = rsb[ai * 128 + wr * 64 + m * 16 + fr];
}
#define MFMA16(a, b, c) __builtin_amdgcn_mfma_f32_16x16x32_bf16((a), (b), (c), 0, 0, 0)

struct EpiWin {
    static constexpr bool PERM = true, AFTER_DRAIN = false;
    unsigned char* ws; int l, lgS; LAS float* rsb;
    __device__ __forceinline__ void operator()(const f32x4 (&acc)[2][2][4][2], const Unit& u, int wr, int wc, int fr, int fq) const {
        const int row0 = u.pm * 256 + wr * 64 + fr, pn = u.pn;
        const float* ss1 = (const float*)(ws + WS_SS1);
        float rs[2][4];
        unit_row_scales(rs, ss1, rsb, u.pm, wr, wc, fr, fq);
        if (pn < 4) {
            bf16_t* base = (bf16_t*)(ws + (pn < 2 ? WS_ZU : WS_ZV)) + (pn & 1) * 256 + wc * 32 + 8 * fq;
#pragma unroll
            for (int ai = 0; ai < 2; ++ai)
#pragma unroll
                for (int m = 0; m < 4; ++m) { const size_t row = row0 + ai * 128 + m * 16;
#pragma unroll
                    for (int bj = 0; bj < 2; ++bj) { float v[8];
#pragma unroll
                        for (int e = 0; e < 8; ++e) v[e] = gelu_tanh(acc[ai][bj][m][e >> 2][e & 3] * rs[ai][m]);
                        *(u32x4*)(base + row * 512 + bj * 128) = pack8(v); } __builtin_amdgcn_sched_barrier(0); }
        } else if (pn < 11) {
            const int hh = 4 * (pn - 4) + wc;
            const float* gp = (const float*)(ws + WS_GT) + (l * NQKH + hh) * 64;
            float g[2][8];
#pragma unroll
            for (int bj = 0; bj < 2; ++bj)
#pragma unroll
                for (int e = 0; e < 8; ++e) g[bj][e] = gp[32 * bj + 8 * fq + e];
            bf16_t* base = (bf16_t*)(ws + WS_QK) + hh * 64 + 8 * fq;
#pragma unroll
            for (int ai = 0; ai < 2; ++ai)
#pragma unroll
                for (int m = 0; m < 4; ++m) { const int rown = row0 + ai * 128 + m * 16; float ssq = 0.f;
                    size_t row = rown;
                    if (hh < 12) { const int lgd = 2 * ((hh < 6 ? hh : hh - 6) >> 1), s = rown & ((1 << lgS) - 1), nn = s >> lgd; row = (size_t)(rown - s) + ((((nn >> 4) << lgd) + (s & ((1 << lgd) - 1))) << 4) + (nn & 15); }
#pragma unroll
                    for (int bj = 0; bj < 2; ++bj)
#pragma unroll
                        for (int e = 0; e < 8; ++e) { const float t = acc[ai][bj][m][e >> 2][e & 3] * rs[ai][m]; ssq += t * t; }
                    ssq = quad_sum(ssq, fq * 16 + fr);
                    const float r = rsqrtf(ssq * (1.f / 64.f) + 1e-6f) * rs[ai][m];
#pragma unroll
                    for (int bj = 0; bj < 2; ++bj) { float v[8];
#pragma unroll
                        for (int e = 0; e < 8; ++e) v[e] = acc[ai][bj][m][e >> 2][e & 3] * r * g[bj][e];
                        *(u32x4*)(base + row * QKP + 32 * bj) = pack8(v); } __builtin_amdgcn_sched_barrier(0); }
        } else if (pn < 15) {
            const int S = 1 << lgS;
#pragma unroll
            for (int bj = 0; bj < 2; ++bj) {
                const int vch0 = (pn - 11) * 256 + 128 * bj + 32 * wc + 8 * fq;
                if (vch0 >= 896) continue;
                const bool isB = vch0 < 384; const int lg = isB ? 2 * (vch0 >> 7) : 0;
#pragma unroll
                for (int ai = 0; ai < 2; ++ai)
#pragma unroll
                    for (int m = 0; m < 4; ++m) { const int row = row0 + ai * 128 + m * 16; const int b = row >> lgS, s = row & (S - 1);
                        const int nn = s >> lg, idx = ((((nn >> 4) << lg) + (s & ((1 << lg) - 1))) << 4) + (nn & 15);
                        bf16_t* dst = isB ? (bf16_t*)(ws + WS_VTB) + ((size_t)(b * 384 + vch0) << lgS) + idx : (bf16_t*)(ws + WS_VTC) + ((size_t)(b * 512 + vch0 - 384) << lgS) + s;
#pragma unroll
                        for (int e = 0; e < 8; e += 2) { const unsigned w = cvt_pk_asm(acc[ai][bj][m][e >> 2][e & 3] * rs[ai][m], acc[ai][bj][m][e >> 2][(e & 3) + 1] * rs[ai][m]);
                            dst[(size_t)e << lgS] = (bf16_t)(w & 0xffffu); dst[(size_t)(e + 1) << lgS] = (bf16_t)(w >> 16); } __builtin_amdgcn_sched_barrier(0); }
            }
        } else {
            bf16_t* base = (bf16_t*)(ws + WS_GATE) + (pn - 15) * 256 + wc * 32 + 8 * fq;
#pragma unroll
            for (int ai = 0; ai < 2; ++ai)
#pragma unroll
                for (int m = 0; m < 4; ++m) { const size_t row = row0 + ai * 128 + m * 16;
#pragma unroll
                    for (int bj = 0; bj < 2; ++bj) { float v[8];
#pragma unroll
                        for (int e = 0; e < 8; ++e) v[e] = sigmoidf_(acc[ai][bj][m][e >> 2][e & 3] * rs[ai][m]);
                        *(u32x4*)(base + row * 3072 + bj * 128) = pack8(v); } __builtin_amdgcn_sched_barrier(0); }
        }
    }
};
struct EpiWp {
    static constexpr bool PERM = true, AFTER_DRAIN = false;
    unsigned char* ws; int BR;
    __device__ __forceinline__ void operator()(const f32x4 (&acc)[2][2][4][2], const Unit& u, int wr, int wc, int fr, int fq) const {
        const int row0 = u.pm * 256 + wr * 64 + fr, col0 = u.pn * 256 + wc * 32 + 8 * fq;
        const bf16_t* gate = (const bf16_t*)(ws + WS_GATE); bf16_t* merged = (bf16_t*)(ws + WS_MERGED);
        u32x4 gwv[2][4][2];
#pragma unroll
        for (int ai = 0; ai < 2; ++ai)
#pragma unroll
            for (int m = 0; m < 4; ++m)
#pragma unroll
                for (int bj = 0; bj < 2; ++bj) gwv[ai][m][bj] = *(const u32x4*)(gate + (size_t)(row0 + ai * 128 + m * 16) * 3072 + BR * 1024 + col0 + bj * 128);
        __builtin_amdgcn_sched_barrier(0);
#pragma unroll
        for (int ai = 0; ai < 2; ++ai)
#pragma unroll
            for (int m = 0; m < 4; ++m) { const size_t row = row0 + ai * 128 + m * 16;
#pragma unroll
                for (int bj = 0; bj < 2; ++bj) { const int col = col0 + bj * 128;
                    const u32x4 gw = gwv[ai][m][bj];
                    float v[8];
                    v[0] = bflo(gw.x) * acc[ai][bj][m][0][0]; v[1] = bfhi(gw.x) * acc[ai][bj][m][0][1]; v[2] = bflo(gw.y) * acc[ai][bj][m][0][2]; v[3] = bfhi(gw.y) * acc[ai][bj][m][0][3];
                    v[4] = bflo(gw.z) * acc[ai][bj][m][1][0]; v[5] = bfhi(gw.z) * acc[ai][bj][m][1][1]; v[6] = bflo(gw.w) * acc[ai][bj][m][1][2]; v[7] = bfhi(gw.w) * acc[ai][bj][m][1][3];
                    bf16_t* mp = merged + row * 1024 + col;
                    if (BR > 0) { const u32x4 pm = *(const u32x4*)mp;
                        v[0] += bflo(pm.x); v[1] += bfhi(pm.x); v[2] += bflo(pm.y); v[3] += bfhi(pm.y); v[4] += bflo(pm.z); v[5] += bfhi(pm.z); v[6] += bflo(pm.w); v[7] += bfhi(pm.w); }
                    *(u32x4*)mp = pack8(v); } }
    }
};
struct EpiRes {
    static constexpr bool PERM = true, AFTER_DRAIN = false;
    float* xout; bf16_t* xb; float* ss; int next;
    __device__ __forceinline__ void operator()(const f32x4 (&acc)[2][2][4][2], const Unit& u, int wr, int wc, int fr, int fq) const {
        const int row0 = u.pm * 256 + wr * 64 + fr, col0 = u.pn * 256 + wc * 32 + 8 * fq;
        u32x4 xwv[2][4][2];
#pragma unroll
        for (int ai = 0; ai < 2; ++ai)
#pragma unroll
            for (int m = 0; m < 4; ++m)
#pragma unroll
                for (int bj = 0; bj < 2; ++bj) xwv[ai][m][bj] = *(const u32x4*)(xb + (size_t)(row0 + ai * 128 + m * 16) * 1024 + col0 + bj * 128);
        __builtin_amdgcn_sched_barrier(0);
#pragma unroll
        for (int ai = 0; ai < 2; ++ai)
#pragma unroll
            for (int m = 0; m < 4; ++m) { const size_t row = row0 + ai * 128 + m * 16; float part = 0.f;
#pragma unroll
                for (int bj = 0; bj < 2; ++bj) { const int col = col0 + bj * 128;
                    const u32x4 xw = xwv[ai][m][bj];
                    float v[8];
                    v[0] = bflo(xw.x) + acc[ai][bj][m][0][0]; v[1] = bfhi(xw.x) + acc[ai][bj][m][0][1]; v[2] = bflo(xw.y) + acc[ai][bj][m][0][2]; v[3] = bfhi(xw.y) + acc[ai][bj][m][0][3];
                    v[4] = bflo(xw.z) + acc[ai][bj][m][1][0]; v[5] = bfhi(xw.z) + acc[ai][bj][m][1][1]; v[6] = bflo(xw.w) + acc[ai][bj][m][1][2]; v[7] = bfhi(xw.w) + acc[ai][bj][m][1][3];
                    if (next) { *(u32x4*)(xb + row * 1024 + col) = pack8(v);
#pragma unroll
                        for (int e = 0; e < 8; ++e) part += v[e] * v[e]; }
                    else { *(f32x4*)(xout + row * 1024 + col) = (f32x4){v[0], v[1], v[2], v[3]}; *(f32x4*)(xout + row * 1024 + col + 4) = (f32x4){v[4], v[5], v[6], v[7]}; } }
                if (next) { part = quad_sum(part, fq * 16 + fr); if (fq == 0) ss[((size_t)u.pn * MC + row) * 4 + wc] = part; } }
    }
};
struct EpiGu {
    static constexpr bool PERM = true, AFTER_DRAIN = false;
    const float* ss2; bf16_t* hid; LAS float* rsb;
    __device__ __forceinline__ void operator()(const f32x4 (&acc)[2][2][4][2], const Unit& u, int wr, int wc, int fr, int fq) const {
        const int row0 = u.pm * 256 + wr * 64 + fr, col0 = u.pn * 128 + wc * 32 + 8 * fq;
        float rsv[2][4];
        unit_row_scales(rsv, ss2, rsb, u.pm, wr, wc, fr, fq);
#pragma unroll
        for (int ai = 0; ai < 2; ++ai)
#pragma unroll
            for (int m = 0; m < 4; ++m) { const size_t row = row0 + ai * 128 + m * 16;
                const float rs = rsv[ai][m]; float v[8];
#pragma unroll
                for (int e = 0; e < 8; ++e) { const float g = acc[ai][0][m][e >> 2][e & 3] * rs, uu = acc[ai][1][m][e >> 2][e & 3] * rs; v[e] = g * sigmoidf_(g) * uu; }
                *(u32x4*)(hid + row * DFF + col0) = pack8(v); }
    }
};

__device__ __forceinline__ int win_src(int n) {
    const int t = n >> 8, w = n & 255;
    if (t < 4) return n;
    if (t < 11) { const int hh = 4 * (t - 4) + ((w & 127) >> 5), d = (w >> 7) * 32;
        const int base = hh < 6 ? 1024 + hh * 64 : hh < 12 ? 1408 + (hh - 6) * 64 : hh < 20 ? 2176 + (hh - 12) * 64 : 2688 + (hh - 20) * 64; return base + d; }
    if (t < 15) { const int v = (t - 11) * 256 + w; return v < 384 ? 1792 + v : v < 896 ? 3200 + (v - 384) : -1; }
    return 3712 + (t - 15) * 256 + w;
}
__device__ __forceinline__ int wgu_src(int n) { const int t = n >> 8, w = n & 255; return w < 128 ? t * 128 + w : DFF + t * 128 + (w - 128); }
__device__ __forceinline__ void cvt_item(const float* W, int K, int N, bf16_t* WT, const float* rscale, int src0, int n0, int k0, LAS float* scr, int lane) {
    if (src0 < 0) {
        const int c = lane & 7;
#pragma unroll
        for (int j = 0; j < 4; ++j) { const int n = (lane >> 3) + 8 * j; *(u32x4*)(WT + (size_t)(n0 + n) * K + k0 + 8 * c) = (u32x4){0u, 0u, 0u, 0u}; }
        return;
    }
#pragma unroll 8
    for (int i = 0; i < 32; ++i) { const int kk = 2 * i + (lane >> 5); float v = W[(size_t)(k0 + kk) * N + src0 + (lane & 31)]; if (rscale) v *= rscale[k0 + kk]; scr[kk * 33 + (lane & 31)] = v; }
    asm volatile("s_waitcnt lgkmcnt(0)" ::: "memory");
    const int c = lane & 7;
#pragma unroll
    for (int j = 0; j < 4; ++j) { const int n = (lane >> 3) + 8 * j; const LAS float* s = scr + (8 * c) * 33 + n;
        u32x4 o; o.x = cvt_pk_bf16(s[0 * 33], s[1 * 33]); o.y = cvt_pk_bf16(s[2 * 33], s[3 * 33]); o.z = cvt_pk_bf16(s[4 * 33], s[5 * 33]); o.w = cvt_pk_bf16(s[6 * 33], s[7 * 33]);
        *(u32x4*)(WT + (size_t)(n0 + n) * K + k0 + 8 * c) = o; }
    asm volatile("s_waitcnt lgkmcnt(0)" ::: "memory");
}
__device__ __forceinline__ int rel_bucket(int rel) {
    const int n = rel < 0 ? -rel : rel; int b;
    if (n < 8) b = n; else b = 8 + (n >= 15) + (n >= 27) + (n >= 50) + (n >= 91) + (n >= 166) + (n >= 305) + (n >= 559);
    return b + (rel > 0 ? 16 : 0);
}
__device__ __forceinline__ void prep_chunk(const float* x, bf16_t* xb, float* ss1, int gw, int ngw, int lane) {
    for (int r0 = gw * 16; r0 < MC; r0 += ngw * 16) {
        float mine = 0.f;
        for (int k = 0; k < 16; ++k) { const int r = r0 + k;
            const f32x4* xr = (const f32x4*)(x + (size_t)r * 1024) + lane; float s = 0.f; f32x4 v[4];
#pragma unroll
            for (int j = 0; j < 4; ++j) { v[j] = xr[64 * j]; s += (v[j][0] * v[j][0] + v[j][1] * v[j][1]) + (v[j][2] * v[j][2] + v[j][3] * v[j][3]); }
            s = wave_sum(s, lane);
            u32x2* o = (u32x2*)(xb + (size_t)r * 1024) + lane;
#pragma unroll
            for (int j = 0; j < 4; ++j) o[64 * j] = (u32x2){cvt_pk_bf16(v[j][0], v[j][1]), cvt_pk_bf16(v[j][2], v[j][3])};
            if (lane == k) mine = s; }
        if (lane < 16) {
#pragma unroll
            for (int pn = 0; pn < 4; ++pn) *(f32x4*)(ss1 + ((size_t)pn * MC + r0 + lane) * 4) = (f32x4){pn == 0 ? mine : 0.f, 0.f, 0.f, 0.f}; }
    }
}
__device__ __forceinline__ void prologue(const Args& a, unsigned char* ws, LAS unsigned char* lds, int gw, int ngw, int wave, int lane) {
    LAS float* scr = (LAS float*)(lds + wave * 8448);
    constexpr int I0 = 3456, I1 = I0 + 256, I2 = I1 + 192, I3 = I2 + 256, I4 = I3 + 512, I5 = I4 + 2816, I6 = I5 + 1408;
    for (int it = gw; it < DEPTH * I6; it += ngw) {
        const int l = it / I6; int r = it % I6; unsigned char* wl = ws + WS_W + (size_t)l * WL;
        if (r < I0) { const int kb = r / 216, nb = r % 216; cvt_item(a.in[I_WIN] + (size_t)l * 1024 * INC, 1024, INC, (bf16_t*)(wl + W_IN), a.in[I_N1G] + l * 1024, win_src(nb * 32), nb * 32, kb * 64, scr, lane); continue; }
        if (r < I1) { r -= I0; const int kb = r / 32, nb = r % 32; cvt_item(a.in[I_WPA] + (size_t)l * 512 * 1024, 512, 1024, (bf16_t*)(wl + W_PA), nullptr, nb * 32, nb * 32, kb * 64, scr, lane); continue; }
        if (r < I2) { r -= I1; const int kb = r / 32, nb = r % 32; cvt_item(a.in[I_WPB] + (size_t)l * 384 * 1024, 384, 1024, (bf16_t*)(wl + W_PB), nullptr, nb * 32, nb * 32, kb * 64, scr, lane); continue; }
        if (r < I3) { r -= I2; const int kb = r / 32, nb = r % 32; cvt_item(a.in[I_WPC] + (size_t)l * 512 * 1024, 512, 1024, (bf16_t*)(wl + W_PC), nullptr, nb * 32, nb * 32, kb * 64, scr, lane); continue; }
        if (r < I4) { r -= I3; const int kb = r / 32, nb = r % 32; cvt_item(a.in[I_WO] + (size_t)l * 1024 * 1024, 1024, 1024, (bf16_t*)(wl + W_O), nullptr, nb * 32, nb * 32, kb * 64, scr, lane); continue; }
        if (r < I5) { r -= I4; const int kb = r / 176, nb = r % 176; cvt_item(a.in[I_WGU] + (size_t)l * 1024 * 2 * DFF, 1024, 2 * DFF, (bf16_t*)(wl + W_GU), a.in[I_N2G] + l * 1024, wgu_src(nb * 32), nb * 32, kb * 64, scr, lane); continue; }
        { r -= I5; const int kb = r / 32, nb = r % 32; cvt_item(a.in[I_WDN] + (size_t)l * DFF * 1024, DFF, 1024, (bf16_t*)(wl + W_DN), nullptr, nb * 32, nb * 32, kb * 64, scr, lane); }
    }
    for (int i = gw * 64 + lane; i < DEPTH * 8 * 128 * 128 / 8; i += ngw * 64) {
        const int l = i / (8 * 128 * 128 / 8), r = i % (8 * 128 * 128 / 8);
        const f32x4 p = *(const f32x4*)(a.in[I_SGUW] + (size_t)i * 8), q = *(const f32x4*)(a.in[I_SGUW] + (size_t)i * 8 + 4);
        *(u32x4*)((bf16_t*)(ws + WS_W + (size_t)l * WL + W_SGU) + (size_t)r * 8) = (u32x4){cvt_pk_bf16(p[0], p[1]), cvt_pk_bf16(p[2], p[3]), cvt_pk_bf16(q[0], q[1]), cvt_pk_bf16(q[2], q[3])};
    }
    float* lut = (float*)(ws + WS_LUT);
    for (int i = gw * 64 + lane; i < 10 * LUTN; i += ngw * 64) { const int h = i / LUTN, rel = (i % LUTN) - LUTOFF; lut[i] = a.in[I_RELB][rel_bucket(rel) * 10 + h] * LOG2E; }
    float* pt = (float*)(ws + WS_PT);
    for (int i = gw * 64 + lane; i < DEPTH * 2176; i += ngw * 64) { const int l = i / 2176, r = i % 2176;
        pt[l * PT_L + r] = r < 128 ? a.in[I_SUBG][l * 128 + r] : r < 640 ? a.in[I_LNG][l * 512 + r - 128] : r < 1152 ? a.in[I_LNB][l * 512 + r - 640] : a.in[I_SGUB][l * 1024 + r - 1152]; }
    if (gw < DEPTH) { const int l = gw;
        const float s1 = wave_sum(a.in[I_LQ1][l * 64 + lane] * a.in[I_LK1][l * 64 + lane], lane), s2 = wave_sum(a.in[I_LQ2][l * 64 + lane] * a.in[I_LK2][l * 64 + lane], lane);
        const float lam_init = 0.8f - 0.6f * expf(-0.3f * (float)l);
        if (lane == 0) { pt[l * PT_L + PT_LAM] = expf(s1) - expf(s2) + lam_init; pt[l * PT_L + PT_LAM + 1] = lam_init; } }
    float* gt = (float*)(ws + WS_GT);
    for (int i = gw * 64 + lane; i < DEPTH * NQKH * 64; i += ngw * 64) { const int l = i / (NQKH * 64), hh = (i / 64) % NQKH, d = i % 64;
        const float* gp = hh < 6 ? a.in[I_QNB] : hh < 12 ? a.in[I_KNB] : hh < 20 ? a.in[I_QNC] : a.in[I_KNC];
        gt[i] = gp[l * 64 + d] * ((hh < 6 || (hh >= 12 && hh < 20)) ? 0.125f * LOG2E : 1.f); }
    prep_chunk(a.in[I_XP], (bf16_t*)(ws + WS_XB), (float*)(ws + WS_SS1), gw, ngw, lane);
}

constexpr int DA_KB = 16384, DA_STG = 32768;
__device__ __forceinline__ void diffattn_item(unsigned char* ws, LAS unsigned char* lds, int l, int lgS, int b, int h, int qb, int tid, int wave, int lane, bool load_lut) {
    const int S = 1 << lgS, T = S >> 6;
    LAS float* lut = (LAS float*)lds;
    LAS unsigned char* stg = lds + 32768;
    const int ql = lane & 15, quad = lane >> 4, q0 = qb * 128 + wave * 16;
    const bf16_t* qkb = (const bf16_t*)(ws + WS_QK) + ((size_t)b << lgS) * QKP;
    const bf16_t* kg[2]; const bf16_t* vg[2];
#pragma unroll
    for (int i = 0; i < 2; ++i) { const int P = (i * 8 + wave) * 64 + lane, key = P >> 4, seg = (P & 15) ^ (key & 15), e = P >> 3, part = (P & 7) ^ ((e >> 1) & 7);
        kg[i] = qkb + (size_t)key * QKP + (20 + (seg >> 3) * 4 + h) * 64 + (seg & 7) * 8;
        vg[i] = (const bf16_t*)(ws + WS_VTC) + ((size_t)(b * 512 + h * 128 + e) << lgS) + part * 8; }
#define DA_DMA(tt, sidx) do { _Pragma("unroll") for (int i = 0; i < 2; ++i) { \
        __builtin_amdgcn_global_load_lds((const unsigned*)(kg[i] + (size_t)(tt) * 64 * QKP), (LAS unsigned*)(stg + (sidx) * DA_STG + (i * 8 + wave) * 1024), 16, 0, 0); \
        __builtin_amdgcn_global_load_lds((const unsigned*)(vg[i] + (tt) * 64), (LAS unsigned*)(stg + (sidx) * DA_STG + DA_KB + (i * 8 + wave) * 1024), 16, 0, 0); } } while (0)
    DA_DMA(0, 0); DA_DMA(1, 1);
    if (load_lut) { const float* glut = (const float*)(ws + WS_LUT) + (6 + h) * LUTN;
      for (int i = tid; i < LUTN; i += 512) lut[i] = glut[i]; }
    bf16x8 qf[2][2];
#pragma unroll
    for (int c = 0; c < 2; ++c)
#pragma unroll
        for (int ks = 0; ks < 2; ++ks) qf[c][ks] = *(const bf16x8*)(qkb + (size_t)(q0 + ql) * QKP + (12 + c * 4 + h) * 64 + 32 * ks + 8 * quad);
    f32x4 o[2][8];
#pragma unroll
    for (int c = 0; c < 2; ++c)
#pragma unroll
        for (int dt = 0; dt < 8; ++dt) o[c][dt] = (f32x4){0.f, 0.f, 0.f, 0.f};
    float lsum0 = 0.f, lsum1 = 0.f;
    const LAS float* lutq = lut + LUTOFF - (q0 + ql) + 4 * quad;
    int kfo[2][2], vfo[2][2];
#pragma unroll
    for (int c = 0; c < 2; ++c)
#pragma unroll
        for (int ks = 0; ks < 2; ++ks) kfo[c][ks] = ql * 256 + (((c * 8 + ks * 4 + quad) ^ ql) << 4);
#pragma unroll
    for (int hf = 0; hf < 2; ++hf)
#pragma unroll
        for (int x = 0; x < 2; ++x) vfo[hf][x] = DA_KB + ql * 128 + (((4 * hf + (quad >> 1) + 2 * x) ^ ((ql >> 1) & 7)) << 4) + 8 * (quad & 1);
    asm volatile("s_waitcnt vmcnt(4) lgkmcnt(0)" ::: "memory"); __builtin_amdgcn_s_barrier(); asm volatile("" ::: "memory");
#define DA_LDK(sbp, hf_) do { _Pragma("unroll") for (int kt = 0; kt < 2; ++kt) _Pragma("unroll") for (int c = 0; c < 2; ++c) _Pragma("unroll") for (int ks = 0; ks < 2; ++ks) \
        kf[kt][c][ks] = *(const LAS bf16x8*)((sbp) + (32 * (hf_) + 16 * kt) * 256 + kfo[c][ks]); } while (0)
#define DA_LDB(k0_) do { _Pragma("unroll") for (int kt = 0; kt < 2; ++kt) _Pragma("unroll") for (int j = 0; j < 4; ++j) biasv[kt][j] = lutq[(k0_) + 16 * kt + j]; } while (0)
    bf16x8 kf[2][2][2]; f32x4 biasv[2];
    DA_LDK(stg, 0); DA_LDB(0);
    int s0 = 0;
    for (int t = 0; t < T; ++t) {
        const int s1 = s0 == 2 ? 0 : s0 + 1, s2 = s1 == 2 ? 0 : s1 + 1;
        if (t + 2 < T) DA_DMA(t + 2, s2);
        const LAS unsigned char* sb = stg + s0 * DA_STG;
#pragma unroll
        for (int hf = 0; hf < 2; ++hf) {
            f32x4 st[2][2];
#pragma unroll
            for (int kt = 0; kt < 2; ++kt)
#pragma unroll
                for (int c = 0; c < 2; ++c) { f32x4 z = MFMA16(kf[kt][c][0], qf[c][0], biasv[kt]); st[c][kt] = MFMA16(kf[kt][c][1], qf[c][1], z); }
            __builtin_amdgcn_sched_barrier(0);
            s16x4 v0[4], v1[4], w0[4], w1[4];
#pragma unroll
            for (int dt = 0; dt < 4; ++dt) { v0[dt] = *(const LAS s16x4*)(sb + dt * 2048 + vfo[hf][0]); v1[dt] = *(const LAS s16x4*)(sb + dt * 2048 + vfo[hf][1]); }
            if (hf == 0) DA_LDK(sb, 1);
            __builtin_amdgcn_sched_barrier(0);
#pragma unroll
            for (int kt = 0; kt < 2; ++kt)
#pragma unroll
                for (int j = 0; j < 4; ++j) { const float p0 = fexp2(st[0][kt][j]), p1 = fexp2(st[1][kt][j]); lsum0 += p0; lsum1 += p1; st[0][kt][j] = p0; st[1][kt][j] = p1; }
            bf16x8 pf[2];
#pragma unroll
            for (int c = 0; c < 2; ++c) { u32x4 w; w.x = cvt_pk_bf16(st[c][0][0], st[c][0][1]); w.y = cvt_pk_bf16(st[c][0][2], st[c][0][3]); w.z = cvt_pk_bf16(st[c][1][0], st[c][1][1]); w.w = cvt_pk_bf16(st[c][1][2], st[c][1][3]);
                pf[c] = __builtin_bit_cast(bf16x8, w); }
            __builtin_amdgcn_sched_barrier(0);
#pragma unroll
            for (int dt = 0; dt < 4; ++dt) { w0[dt] = *(const LAS s16x4*)(sb + (dt + 4) * 2048 + vfo[hf][0]); w1[dt] = *(const LAS s16x4*)(sb + (dt + 4) * 2048 + vfo[hf][1]); }
            if (hf == 0) DA_LDB(t * 64 + 32);
#pragma unroll
            for (int dt = 0; dt < 4; ++dt) { const bf16x8 vf = __builtin_shufflevector(v0[dt], v1[dt], 0, 1, 2, 3, 4, 5, 6, 7);
                o[0][dt] = MFMA16(vf, pf[0], o[0][dt]); o[1][dt] = MFMA16(vf, pf[1], o[1][dt]); }
            __builtin_amdgcn_sched_barrier(0);
#pragma unroll
            for (int dt = 0; dt < 4; ++dt) { const bf16x8 vf = __builtin_shufflevector(w0[dt], w1[dt], 0, 1, 2, 3, 4, 5, 6, 7);
                o[0][dt + 4] = MFMA16(vf, pf[0], o[0][dt + 4]); o[1][dt + 4] = MFMA16(vf, pf[1], o[1][dt + 4]); }
            __builtin_amdgcn_sched_barrier(0);
        }
        if (t + 2 < T) asm volatile("s_waitcnt vmcnt(4) lgkmcnt(0)" ::: "memory"); else asm volatile("s_waitcnt vmcnt(0) lgkmcnt(0)" ::: "memory");
        __builtin_amdgcn_s_barrier(); asm volatile("" ::: "memory");
        __builtin_amdgcn_sched_barrier(0);
        if (t + 1 < T) { DA_LDK(stg + s1 * DA_STG, 0); DA_LDB((t + 1) * 64); }
        s0 = s1;
    }
#undef DA_LDB
#undef DA_LDK
#undef DA_DMA
    lsum0 = quad_sum(lsum0, lane); lsum1 = quad_sum(lsum1, lane);
    const float* pt = (const float*)(ws + WS_PT) + l * PT_L;
    const float lam = pt[PT_LAM], lam_init = pt[PT_LAM + 1];
    const float i1 = 1.f / lsum0, i2 = lam / lsum1; float ssq = 0.f;
#pragma unroll
    for (int dt = 0; dt < 8; ++dt)
#pragma unroll
        for (int j = 0; j < 4; ++j) { const float v = o[0][dt][j] * i1 - o[1][dt][j] * i2; o[0][dt][j] = v; ssq += v * v; }
    ssq = quad_sum(ssq, lane);
    const float r = rsqrtf(ssq * (1.f / 128.f) + 1e-6f) * (1.f - lam_init);
    bf16_t* outp = (bf16_t*)(ws + WS_COUT) + ((size_t)(b << lgS) + q0 + ql) * 512 + h * 128 + 4 * quad;
    const float* sg = pt + PT_SUBG + 4 * quad;
#pragma unroll
    for (int dt = 0; dt < 8; ++dt) { const f32x4 g = *(const f32x4*)(sg + 16 * dt);
        *(u32x2*)(outp + 16 * dt) = (u32x2){cvt_pk_bf16(o[0][dt][0] * r * g[0], o[0][dt][1] * r * g[1]), cvt_pk_bf16(o[0][dt][2] * r * g[2], o[0][dt][3] * r * g[3])}; }
}

__device__ __forceinline__ void dilattn_item(unsigned char* ws, LAS unsigned char* lds, int lgS, int b, int sp, int j, int tid, int wave, int lane) {
    const int S = 1 << lgS;
    const int ql = lane & 15, quad = lane >> 4;
    const bf16_t* qkb = (const bf16_t*)(ws + WS_QK) + ((size_t)b << lgS) * QKP;
    bf16_t* bout = (bf16_t*)(ws + WS_BOUT) + ((size_t)b << lgS) * 384;
    float* lb = (float*)(ws + WS_LB) + ((size_t)j * MC + ((size_t)b << lgS)) * 4;
    const float* glut = (const float*)(ws + WS_LUT);
    LAS float* lutl = (LAS float*)lds;
#pragma unroll
    for (int i0 = 0; i0 < 3 * 4096; i0 += 512) { const int i = i0 + tid; lutl[i] = glut[(2 * (i >> 12) + j) * LUTN + LUTOFF - 2048 + (i & 4095)]; }
    __syncthreads();
    for (int uu = wave; uu < 48; uu += 8) {
        const int gi = uu >> 4, u = uu & 15, lg = 2 * gi, dil = 1 << lg, r = u & (dil - 1), n0 = (sp << (8 - lg)) + 16 * (u >> lg), L = S >> lg, hh = 2 * gi + j;
        const int tokq = ((n0 + ql) << lg) + r;
        bf16x8 qf[2];
#pragma unroll
        for (int ks = 0; ks < 2; ++ks) qf[ks] = *(const bf16x8*)(qkb + (size_t)(((((n0 >> 4) << lg) + r) << 4) + ql) * QKP + hh * 64 + 32 * ks + 8 * quad);
        f32x4 st[10];
#pragma unroll
        for (int kt = 0; kt < 10; ++kt) { int n = n0 - 64 + 32 * (kt >> 1) + 8 * (ql >> 2) + 4 * (kt & 1) + (ql & 3); n = n < 0 ? 0 : (n > L - 1 ? L - 1 : n);
            const bf16_t* kp = qkb + (size_t)(((((n >> 4) << lg) + r) << 4) + (n & 15)) * QKP + (6 + hh) * 64 + 8 * quad;
            const bf16x8 ka0 = *(const bf16x8*)kp, ka1 = *(const bf16x8*)(kp + 32);
            f32x4 z = (f32x4){0.f, 0.f, 0.f, 0.f}; z = MFMA16(ka0, qf[0], z); st[kt] = MFMA16(ka1, qf[1], z); }
        float lsum = 0.f;
        const LAS float* lutp = lutl + gi * 4096 + 2048;
#pragma unroll
        for (int kt = 0; kt < 10; ++kt)
#pragma unroll
            for (int e = 0; e < 4; ++e) { const int n = n0 - 64 + 32 * (kt >> 1) + 8 * quad + 4 * (kt & 1) + e, rel = n - (n0 + ql);
                const bool valid = (n >= 0) && (n < L) && (rel <= 64) && (rel >= -64);
                const float bias = lutp[rel * dil];
                const float p = valid ? fexp2(st[kt][e] + bias) : 0.f; lsum += p; st[kt][e] = p; }
        f32x4 o[4];
#pragma unroll
        for (int dt = 0; dt < 4; ++dt) o[dt] = (f32x4){0.f, 0.f, 0.f, 0.f};
        const bf16_t* vb = (const bf16_t*)(ws + WS_VTB) + ((size_t)(b * 384 + hh * 64 + ql) << lgS);
#pragma unroll
        for (int i = 0; i < 5; ++i) {
            u32x4 w; w.x = cvt_pk_bf16(st[2 * i][0], st[2 * i][1]); w.y = cvt_pk_bf16(st[2 * i][2], st[2 * i][3]); w.z = cvt_pk_bf16(st[2 * i + 1][0], st[2 * i + 1][1]); w.w = cvt_pk_bf16(st[2 * i + 1][2], st[2 * i + 1][3]);
            const bf16x8 pf = __builtin_bit_cast(bf16x8, w);
            int na = n0 - 64 + 32 * i + 8 * quad;
            na = na < 0 ? 0 : (na > L - 8 ? L - 8 : na);
#pragma unroll
            for (int dt = 0; dt < 4; ++dt) { const bf16_t* vp = vb + ((size_t)(dt * 16) << lgS);
                const bf16x8 vf = *(const bf16x8*)(vp + (((((na >> 4) << lg) + r) << 4) + (na & 15)));
                o[dt] = MFMA16(vf, pf, o[dt]); }
        }
        lsum = quad_sum(lsum, lane);
        bf16_t* op = bout + (size_t)tokq * 384 + hh * 64 + 4 * quad;
#pragma unroll
        for (int dt = 0; dt < 4; ++dt) *(u32x2*)(op + 16 * dt) = (u32x2){cvt_pk_bf16(o[dt][0], o[dt][1]), cvt_pk_bf16(o[dt][2], o[dt][3])};
        if (quad == 0) lb[(size_t)tokq * 4 + gi] = lsum;
    }
    asm volatile("s_waitcnt vmcnt(0)" ::: "memory"); __builtin_amdgcn_fence(__ATOMIC_SEQ_CST, "workgroup"); __syncthreads(); __builtin_amdgcn_fence(__ATOMIC_SEQ_CST, "workgroup");
    for (int idx = tid; idx < 256 * 24; idx += 512) {
        const int tok = sp * 256 + idx / 24, rem = idx % 24, gi = rem >> 3, piece = rem & 7, hh = 2 * gi + j;
        const f32x4 lp = *(const f32x4*)(lb + (size_t)tok * 4);
        const float inv = 1.f / (lp[0] + lp[1] + lp[2]);
        u32x4* p = (u32x4*)(bout + (size_t)tok * 384 + hh * 64 + piece * 8); const u32x4 w = *p;
        u32x4 o; o.x = cvt_pk_bf16(bflo(w.x) * inv, bfhi(w.x) * inv); o.y = cvt_pk_bf16(bflo(w.y) * inv, bfhi(w.y) * inv); o.z = cvt_pk_bf16(bflo(w.z) * inv, bfhi(w.z) * inv); o.w = cvt_pk_bf16(bflo(w.w) * inv, bfhi(w.w) * inv);
        *p = o;
    }
    __syncthreads();
}

__device__ __forceinline__ void sgu_item(unsigned char* ws, LAS unsigned char* lds, int l, int ci, int tid, int wave, int lane) {
    const float* ptab = (const float*)(ws + WS_PT) + l * PT_L;
    typedef float f32x2 __attribute__((ext_vector_type(2)));
    LAS f32x2* stats = (LAS f32x2*)lds;
    LAS unsigned char* img = lds + 1024 + wave * 17408;
    const bf16_t* zv = (const bf16_t*)(ws + WS_ZV) + (size_t)ci * 128 * 512;
    const bf16_t* zu = (const bf16_t*)(ws + WS_ZU) + (size_t)ci * 128 * 512;
    bf16_t* aout = (bf16_t*)(ws + WS_AOUT) + (size_t)ci * 128 * 512;
#pragma unroll
    for (int t = 0; t < 16; ++t) { const int tok = wave * 16 + t;
        const u32x4 w = *(const u32x4*)(zv + (size_t)tok * 512 + lane * 8);
        float v[8] = {bflo(w.x), bfhi(w.x), bflo(w.y), bfhi(w.y), bflo(w.z), bfhi(w.z), bflo(w.w), bfhi(w.w)};
        float s = 0.f;
#pragma unroll
        for (int e = 0; e < 8; ++e) s += v[e];
        const float mean = wave_sum(s, lane) * (1.f / 512.f); float s2 = 0.f;
#pragma unroll
        for (int e = 0; e < 8; ++e) { const float d = v[e] - mean; s2 += d * d; }
        const float rstd = rsqrtf(wave_sum(s2, lane) * (1.f / 512.f) + 1e-5f);
        if (lane == 0) stats[tok] = (f32x2){mean, rstd}; }
    __syncthreads();
    const int g = wave;
    { const int tl = lane >> 3, cp = lane & 7; float gam[8], bet[8];
#pragma unroll
      for (int e = 0; e < 8; ++e) { gam[e] = ptab[PT_LNG + g * 64 + 8 * cp + e]; bet[e] = ptab[PT_LNB + g * 64 + 8 * cp + e]; }
#pragma unroll
      for (int it = 0; it < 16; ++it) { const int tok = 8 * it + tl; const f32x2 ms = stats[tok];
          const u32x4 w = *(const u32x4*)(zv + (size_t)tok * 512 + g * 64 + 8 * cp);
          float v[8] = {bflo(w.x), bfhi(w.x), bflo(w.y), bfhi(w.y), bflo(w.z), bfhi(w.z), bflo(w.w), bfhi(w.w)};
#pragma unroll
          for (int e = 0; e < 8; ++e) v[e] = (v[e] - ms[0]) * ms[1] * gam[e] + bet[e];
          LAS unsigned char* dp = img + tok * 136 + (cp >> 2) * 64 + (cp & 3) * 8;
          *(LAS u32x2*)dp = (u32x2){cvt_pk_bf16(v[0], v[1]), cvt_pk_bf16(v[2], v[3])}; *(LAS u32x2*)(dp + 32) = (u32x2){cvt_pk_bf16(v[4], v[5]), cvt_pk_bf16(v[6], v[7])}; } }
    __syncthreads();
    const int ql = lane & 15, quad = lane >> 4;
    typedef short v4i16_t __attribute__((ext_vector_type(4)));
    bf16x8 af[4][4];
#pragma unroll
    for (int dt = 0; dt < 4; ++dt)
#pragma unroll
        for (int ks = 0; ks < 4; ++ks) {
            const LAS unsigned char* p0 = img + (32 * ks + 8 * quad + (ql >> 2)) * 136 + 32 * dt + 8 * (ql & 3);
            const s16x4 t0 = __builtin_bit_cast(s16x4, __builtin_amdgcn_ds_read_tr16_b64_v4i16((LAS v4i16_t*)p0));
            const s16x4 t1 = __builtin_bit_cast(s16x4, __builtin_amdgcn_ds_read_tr16_b64_v4i16((LAS v4i16_t*)(p0 + 4 * 136)));
            af[dt][ks] = __builtin_shufflevector(t0, t1, 0, 1, 2, 3, 4, 5, 6, 7); }
    const bf16_t* wg = (const bf16_t*)(ws + WS_W + (size_t)l * WL + W_SGU) + (size_t)g * 128 * 128;
#pragma unroll 2
    for (int pt = 0; pt < 8; ++pt) {
        f32x4 acc[4];
#pragma unroll
        for (int dt = 0; dt < 4; ++dt) acc[dt] = (f32x4){0.f, 0.f, 0.f, 0.f};
#pragma unroll
        for (int ks = 0; ks < 4; ++ks) { const bf16x8 bfr = *(const bf16x8*)(wg + (size_t)(16 * pt + ql) * 128 + 32 * ks + 8 * quad);
#pragma unroll
            for (int dt = 0; dt < 4; ++dt) acc[dt] = MFMA16(af[dt][ks], bfr, acc[dt]); }
        const int tok = 16 * pt + ql; const float bias = ptab[PT_SGUB + g * 128 + tok];
#pragma unroll
        for (int k = 0; k < 2; ++k) { const int col = g * 64 + 32 * k + 8 * quad;
            const u32x4 uw = *(const u32x4*)(zu + (size_t)tok * 512 + col);
            u32x4 ow;
            ow.x = cvt_pk_bf16(bflo(uw.x) * (acc[2 * k][0] + bias), bfhi(uw.x) * (acc[2 * k][1] + bias)); ow.y = cvt_pk_bf16(bflo(uw.y) * (acc[2 * k][2] + bias), bfhi(uw.y) * (acc[2 * k][3] + bias));
            ow.z = cvt_pk_bf16(bflo(uw.z) * (acc[2 * k + 1][0] + bias), bfhi(uw.z) * (acc[2 * k + 1][1] + bias)); ow.w = cvt_pk_bf16(bflo(uw.w) * (acc[2 * k + 1][2] + bias), bfhi(uw.w) * (acc[2 * k + 1][3] + bias));
            *(u32x4*)(aout + (size_t)tok * 512 + col) = ow; }
    }
    __syncthreads();
}

#ifndef PHM
#define PHM 127
#endif
#ifndef IM
#define IM 7
#endif
#define GRID_SYNC() do { asm volatile("s_waitcnt vmcnt(0)" ::: "memory"); __syncthreads(); \
    grid.sync(); \
    if (threadIdx.x < 64) { __builtin_amdgcn_fence(__ATOMIC_ACQUIRE, "agent"); asm volatile("s_waitcnt vmcnt(0)" ::: "memory"); } __syncthreads(); } while (0)
__global__ void __launch_bounds__(512, 2) fwd(Args a) {
    extern __shared__ __attribute__((aligned(16))) unsigned char lds_raw[];
    LAS unsigned char* lds = (LAS unsigned char*)lds_raw;
    cg::grid_group grid = cg::this_grid();
    int s = a.lo;
    if (s == 0) {
        unsigned char* ws = a.ws; int tid = threadIdx.x, bx = blockIdx.x, G = gridDim.x;
        const int lane = tid & 63, wave = __builtin_amdgcn_readfirstlane(tid >> 6), gw = bx * 8 + wave, ngw = G * 8;
        if (PHM & 1) prologue(a, ws, lds, gw, ngw, wave, lane);
        ++s; if (s < a.hi) GRID_SYNC();
    }
#ifdef PROBE_P
    int probe_rep = 0;
#ifdef PROBE_IM
#define PROBE_SEL(x) (!probe_rep || (PROBE_IM & (x)))
#else
#define PROBE_SEL(x) true
#endif
#else
#define PROBE_SEL(x) true
#endif
    for (; s < a.hi; ++s) {
        size_t zo = 0; int bx = blockIdx.x, G = gridDim.x;
        asm volatile("" : "+s"(zo), "+s"(bx), "+s"(G));
        unsigned char* ws = a.ws + zo;
        const int t = s - 1, c = t / 24, l = (t % 24) / 6, p = t % 6;
        const int lgS = c < 2 ? 11 : 12;
        unsigned char* wl = ws + WS_W + (size_t)l * WL;
        const size_t xbo = (c & 1) ? WS_XB2 : WS_XB, xbn = (c & 1) ? WS_XB : WS_XB2;
        if (p == 0 && (PHM & 2)) {
            pg8::Gemm g{(const bf16_t*)(ws + xbo), (const bf16_t*)(wl + W_IN), MC, ZN, 1024}; pg8::StaticOrder S; S.init(MC, ZN, G, bx);
            EpiWin E{ws, l, lgS, (LAS float*)(lds + 131072)};
            pg8::gemm_phase<EpiWin, pg8::StaticOrder, true, true>(lds, g, S, E);
        } else if (p == 1 && (PHM & 4)) {
            int tid = threadIdx.x; asm volatile("" : "+v"(tid));
            const int lane = tid & 63, wave = __builtin_amdgcn_readfirstlane(tid >> 6);
            const int nqb = (1 << lgS) / 128, NC = (MC / 128) * 4, NB = (MC / 256) * 2, NA = MC / 128;
            {
            const int vbx = (G & 7) == 0 ? (bx & 7) * (G >> 3) + (bx >> 3) : bx;
            if ((IM & 1) && PROBE_SEL(1)) { int lut_h = -1; for (int it = vbx; it < NC; it += G) { const int qb = it % nqb, bh = it / nqb; diffattn_item(ws, lds, l, lgS, bh >> 2, bh & 3, qb, tid, wave, lane, (bh & 3) != lut_h); lut_h = bh & 3; } }
            if ((IM & 2) && PROBE_SEL(2)) for (int it = bx; it < NB; it += G) { const int j = it & 1, gsp = it >> 1, nsp = (1 << lgS) / 256; dilattn_item(ws, lds, lgS, gsp / nsp, gsp % nsp, j, tid, wave, lane); }
            if ((IM & 4) && PROBE_SEL(4)) for (int it = bx; it < NA; it += G) sgu_item(ws, lds, l, it, tid, wave, lane);
            }
        } else if (p == 2 && (PHM & 8)) {
            pg8::StaticOrder S; S.init(MC, 1024, G, bx);
#pragma nounroll
            for (int br = 0; br < 3; ++br) {
                const size_t aoff = br == 0 ? WS_AOUT : br == 1 ? WS_BOUT : WS_COUT, woff = br == 0 ? W_PA : br == 1 ? W_PB : W_PC;
                pg8::Gemm g{(const bf16_t*)(ws + aoff), (const bf16_t*)(wl + woff), MC, 1024, br == 1 ? 384 : 512}; EpiWp E{ws, br};
                pg8::gemm_phase<EpiWp, pg8::StaticOrder, true, true>(lds, g, S, E);
            }
        } else if ((p == 3 && (PHM & 16)) || (p == 5 && (PHM & 64))) {
            float* xout = a.out + (size_t)c * MC * 1024 + zo;
            const bool wo = p == 3;
            pg8::Gemm g{(const bf16_t*)(ws + (wo ? WS_MERGED : WS_HID)), (const bf16_t*)(wl + (wo ? W_O : W_DN)), MC, 1024, wo ? 1024 : DFF}; pg8::StaticOrder S; S.init(MC, 1024, G, bx);
            EpiRes E{xout, (bf16_t*)(ws + xbo), (float*)(ws + (wo ? WS_SS2 : WS_SS1)), (wo || l < DEPTH - 1) ? 1 : 0};
            pg8::gemm_phase<EpiRes, pg8::StaticOrder, true, true>(lds, g, S, E);
            if (!wo && l == DEPTH - 1 && c + 1 < NCHUNK) {
                int tid = threadIdx.x; asm volatile("" : "+v"(tid));
                const int lane = tid & 63, wave = __builtin_amdgcn_readfirstlane(tid >> 6);
                const float* xn = ((c + 1) < 2 ? a.in[I_XP] + (size_t)(c + 1) * MC * 1024 : a.in[I_XS]) + zo;
                prep_chunk(xn, (bf16_t*)(ws + xbn), (float*)(ws + WS_SS1), bx * 8 + wave, G * 8, lane);
            }
        } else if (p == 4 && (PHM & 32)) {
            pg8::Gemm g{(const bf16_t*)(ws + xbo), (const bf16_t*)(wl + W_GU), MC, 2 * DFF, 1024}; pg8::StaticOrder S; S.init(MC, 2 * DFF, G, bx);
            EpiGu E{(const float*)(ws + WS_SS2), (bf16_t*)(ws + WS_HID), (LAS float*)(lds + 131072)};
            pg8::gemm_phase<EpiGu, pg8::StaticOrder, true, true>(lds, g, S, E);
        }
        if (s + 1 < a.hi) GRID_SYNC();
#ifdef PROBE_P
        if (p == PROBE_P && !probe_rep) { probe_rep = 1; --s; } else probe_rep = 0;
#endif
    }
}

#ifndef MK_MULTI
#define MK_MULTI 0
#endif
extern "C" void kernel_launch(void* const* d_in, const int* in_sizes, int n_in, void* d_out, int out_size, void* d_ws, size_t ws_size, hipStream_t stream) {
    static int grid = 0;
    if (grid == 0) {
        if (n_in != 25 || ws_size < WS_END) { fprintf(stderr, "kernel_launch: need 25 inputs and %zu bytes of workspace (got %d, %zu)\n", (size_t)WS_END, n_in, ws_size); grid = -1; return; }
        int dev = 0, cus = 0, per_cu = 0;
        if (hipGetDevice(&dev) != hipSuccess || hipDeviceGetAttribute(&cus, hipDeviceAttributeMultiprocessorCount, dev) != hipSuccess) { grid = -1; return; }
        if (hipFuncSetAttribute((const void*)fwd, hipFuncAttributeMaxDynamicSharedMemorySize, LDS_BYTES) != hipSuccess) { fprintf(stderr, "kernel_launch: hipFuncSetAttribute failed\n"); grid = -1; return; }
        if (hipOccupancyMaxActiveBlocksPerMultiprocessor(&per_cu, (const void*)fwd, 512, LDS_BYTES) != hipSuccess || per_cu < 1) per_cu = 1;
        (void)hipGetLastError();
        grid = cus * per_cu;
        fprintf(stderr, "kernel_launch: grid %d (%d CUs x %d), ws %zu\n", grid, cus, per_cu, ws_size);
    }
    if (grid < 0) return;
    Args a{};
    for (int i = 0; i < 25; ++i) a.in[i] = (const float*)d_in[i];
    a.out = (float*)d_out; a.ws = (unsigned char*)d_ws;
#if MK_MULTI
    for (int s = 0; s < NSTEPS; ++s) { a.lo = s; a.hi = s + 1; void* args[] = {&a};
        hipError_t e = hipLaunchCooperativeKernel((const void*)fwd, dim3(grid), dim3(512), args, LDS_BYTES, stream);
        if (e != hipSuccess) { fprintf(stderr, "kernel_launch: launch %d failed: %s\n", s, hipGetErrorString(e)); break; } }
#else
    a.lo = 0; a.hi = NSTEPS; void* args[] = {&a};
    hipError_t e = hipLaunchCooperativeKernel((const void*)fwd, dim3(grid), dim3(512), args, LDS_BYTES, stream);
    if (e != hipSuccess) fprintf(stderr, "kernel_launch: cooperative launch failed: %s (grid %d)\n", hipGetErrorString(e), grid);
#endif
}
```
